# Optimizing an MI355X kernel written in HIP

```python
import jax, jax.numpy as jnp
from jax import lax
import numpy as np

D_MODEL = 1024
BATCH = 32
SEQ = 256
DEPTH = 2
DEC_BATCH = 8
DEC_SEQ = 1024
PAST_LEN = 256

GRID_W = 64
CONV_DIM = 512
CONV_K = 3
NA_HEADS = 8
NA_HD = 64
NA_WIN_R = 8
NA_WIN_C = 16
MLA_HEADS = 8
MLA_NOPE = 64
MLA_ROPE = 32
MLA_V = 64
Q_LORA = 256
KV_LORA = 128
FFN_DIM = 2816
N_BRANCH = 3
N_MOD = 9
ROPE_BASE = 10000.0
EPS = 1e-6
Q_BLOCK = 128
NEG_INF = -1e30
MLA_SCALE = (MLA_NOPE + MLA_ROPE) ** -0.5
NA_SCALE = NA_HD ** -0.5
IN_SPLITS = (CONV_DIM, CONV_DIM, CONV_DIM,
             NA_HEADS * NA_HD, NA_HEADS * NA_HD, NA_HEADS * NA_HD,
             Q_LORA, KV_LORA, MLA_ROPE,
             D_MODEL, D_MODEL, D_MODEL)
IN_DIM = 3 * CONV_DIM + 3 * NA_HEADS * NA_HD + Q_LORA + KV_LORA + MLA_ROPE + N_BRANCH * D_MODEL

kernel_name = "hybrid_diffusion_conv_na_mla_step"


def rmsnorm(x, g):
    xf = x.astype(jnp.float32)
    y = xf * lax.rsqrt(jnp.mean(xf * xf, axis=-1, keepdims=True) + EPS)
    return (y * g.astype(jnp.float32)).astype(x.dtype)


def modulate(h, shift, scale):
    return h * (1 + scale) + shift


def swiglu(h, w_gate, w_up, w_down):
    return (jax.nn.silu(h @ w_gate) * (h @ w_up)) @ w_down


def split_cols(u, sizes):
    out, off = [], 0
    for n in sizes:
        out.append(u[..., off:off + n])
        off += n
    return out


def to_heads(t, n_heads):
    b, s, _ = t.shape
    return t.reshape(b, s, n_heads, -1).transpose(0, 2, 1, 3)


def from_heads(t):
    b, h, s, d = t.shape
    return t.transpose(0, 2, 1, 3).reshape(b, s, h * d)


def short_conv(u, w, bias):
    s = u.shape[1]
    pad = CONV_K // 2
    up = jnp.pad(u, ((0, 0), (pad, pad), (0, 0)))
    y = bias
    for i in range(CONV_K):
        y = y + up[:, i:i + s] * w[i]
    return y


def axial_rope(x, rows, cols):
    half = MLA_ROPE // 2
    nf = half // 2
    inv = 1.0 / (ROPE_BASE ** (jnp.arange(nf, dtype=jnp.float32) / nf))

    def rot(xh, pos):
        ang = pos.astype(jnp.float32)[:, None] * inv[None, :]
        cos = jnp.cos(ang).astype(x.dtype)
        sin = jnp.sin(ang).astype(x.dtype)
        x1, x2 = xh[..., :nf], xh[..., nf:]
        return jnp.concatenate([x1 * cos - x2 * sin, x1 * sin + x2 * cos], axis=-1)

    return jnp.concatenate([rot(x[..., :half], rows), rot(x[..., half:], cols)], axis=-1)


def attend_blocked(q, k, v, scale):
    b, h, sq, d = q.shape
    nb = sq // Q_BLOCK
    qb = q.reshape(b, h, nb, Q_BLOCK, d).transpose(2, 0, 1, 3, 4)

    def one(qi):
        s = jnp.einsum('bhqd,bhkd->bhqk', qi, k).astype(jnp.float32) * scale
        p = jax.nn.softmax(s, axis=-1).astype(v.dtype)
        return jnp.einsum('bhqk,bhkd->bhqd', p, v)

    o = lax.map(one, qb)
    return o.transpose(1, 2, 0, 3, 4).reshape(b, h, sq, v.shape[-1])


def neighbourhood_attention(q, k, v, k_ctx, v_ctx, rpb):
    b, h, s, hd = q.shape
    rows = s // GRID_W
    kr = min(NA_WIN_R, rows)
    r = jnp.arange(rows)
    col = jnp.arange(GRID_W)
    row_idx = jnp.clip(r - kr // 2, 0, rows - kr)[:, None] + jnp.arange(kr)[None, :]
    col_start = jnp.clip(col - NA_WIN_C // 2, 0, GRID_W - NA_WIN_C)
    col_rel = col[None, :] - col_start[:, None]
    col_in = (col_rel >= 0) & (col_rel < NA_WIN_C)
    dr = row_idx - r[:, None] + (NA_WIN_R - 1)
    dc = jnp.clip(col[None, :] - col[:, None] + (NA_WIN_C - 1), 0, 2 * NA_WIN_C - 2)
    bias = rpb[:, dr[:, None, :, None], dc[None, :, None, :]].astype(jnp.float32)
    qg = q.reshape(b, h, rows, GRID_W, hd)
    kg = k.reshape(b, h, rows, GRID_W, hd)[:, :, row_idx]
    vg = v.reshape(b, h, rows, GRID_W, hd)[:, :, row_idx]
    s_loc = jnp.einsum('bhrqd,bhrikd->bhrqik', qg, kg).astype(jnp.float32) * NA_SCALE + bias[None]
    s_loc = jnp.where(col_in[:, None, :], s_loc, NEG_INF)
    s_loc = s_loc.reshape(b, h, rows, GRID_W, kr * GRID_W)
    s_ctx = jnp.einsum('bhrqd,bhpd->bhrqp', qg, k_ctx).astype(jnp.float32) * NA_SCALE
    prob = jax.nn.softmax(jnp.concatenate([s_loc, s_ctx], axis=-1), axis=-1).astype(v.dtype)
    p_loc = prob[..., :kr * GRID_W].reshape(b, h, rows, GRID_W, kr, GRID_W)
    p_ctx = prob[..., kr * GRID_W:]
    o = (jnp.einsum('bhrqik,bhrikd->bhrqd', p_loc, vg)
         + jnp.einsum('bhrqp,bhpd->bhrqd', p_ctx, v_ctx))
    return o.reshape(b, h, s, hd)


def mla_expand(c_kv, k_r, w_ukv):
    kv = to_heads(c_kv @ w_ukv, MLA_HEADS)
    k_nope, v = kv[..., :MLA_NOPE], kv[..., MLA_NOPE:]
    b, h, s, _ = k_nope.shape
    k_rope = jnp.broadcast_to(k_r[:, None], (b, h, s, MLA_ROPE))
    return jnp.concatenate([k_nope, k_rope], axis=-1), v


def layer(x, mod, p, ctx=None):
    s = x.shape[1]
    m = lambda i: mod[:, :, i]
    ng = p['norm_g']
    h = modulate(rmsnorm(x, ng[0]), m(0), m(1))
    x = x + 0.5 * m(2) * swiglu(h, p['w_ffn1_gate'], p['w_ffn1_up'], p['w_ffn1_down'])
    h = modulate(rmsnorm(x, ng[1]), m(3), m(4))
    (b_g, c_g, x_c, q_na, k_na, v_na, c_q, c_kv, k_r,
     g_conv, g_na, g_mla) = split_cols(h @ p['w_in'], IN_SPLITS)
    y_conv = b_g * short_conv(c_g * x_c, p['conv_w'], p['conv_b'])
    q_na, k_na, v_na = to_heads(q_na, NA_HEADS), to_heads(k_na, NA_HEADS), to_heads(v_na, NA_HEADS)
    q_m = to_heads(rmsnorm(c_q, p['mla_qnorm']) @ p['w_uq'], MLA_HEADS)
    c_kv = rmsnorm(c_kv, p['mla_kvnorm'])
    if ctx is None:
        o_na = attend_blocked(q_na, k_na, v_na, NA_SCALE)
        k_m, v_m = mla_expand(c_kv, k_r, p['w_ukv'])
        o_m = attend_blocked(q_m, k_m, v_m, MLA_SCALE)
        new = (k_na, v_na, c_kv, k_r)
    else:
        ck_na, cv_na, cc_kv, ck_r = ctx
        o_na = neighbourhood_attention(q_na, k_na, v_na, ck_na, cv_na, p['na_rpb'])
        t = jnp.arange(s)
        rows, cols = t // GRID_W, t % GRID_W
        q_m = jnp.concatenate([q_m[..., :MLA_NOPE], axial_rope(q_m[..., MLA_NOPE:], rows, cols)], axis=-1)
        k_lat, v_lat = mla_expand(c_kv, axial_rope(k_r, rows, cols), p['w_ukv'])
        k_ctx, v_ctx = mla_expand(cc_kv, ck_r, p['w_ukv'])
        o_m = attend_blocked(q_m, jnp.concatenate([k_ctx, k_lat], axis=2),
                             jnp.concatenate([v_ctx, v_lat], axis=2), MLA_SCALE)
        new = None
    z = (jax.nn.sigmoid(g_conv) * (y_conv @ p['w_conv_out'])
         + jax.nn.sigmoid(g_na) * (from_heads(o_na) @ p['w_na_out'])
         + jax.nn.sigmoid(g_mla) * (from_heads(o_m) @ p['w_mla_out']))
    x = x + m(5) * (z @ p['w_o'])
    h = modulate(rmsnorm(x, ng[2]), m(6), m(7))
    x = x + 0.5 * m(8) * swiglu(h, p['w_ffn2_gate'], p['w_ffn2_up'], p['w_ffn2_down'])
    return x, new


def setup_inputs(seed: int = 0) -> dict:
    key = jax.random.key(seed)
    ks = jax.random.split(key, 32)
    f32 = jnp.float32

    def nrm(k, shape, scale):
        return jax.random.normal(k, shape, f32) * scale

    D, L, F = D_MODEL, DEPTH, FFN_DIM
    return {
        'x_prompt': nrm(ks[0], (BATCH, SEQ, D), 1.0),
        'x_sample': nrm(ks[1], (DEC_BATCH, DEC_SEQ, D), 1.0),
        'cache_na_k': nrm(ks[2], (DEC_BATCH, L, NA_HEADS, PAST_LEN, NA_HD), 1.0),
        'cache_na_v': nrm(ks[3], (DEC_BATCH, L, NA_HEADS, PAST_LEN, NA_HD), 1.0),
        'cache_mla_ckv': nrm(ks[4], (DEC_BATCH, L, PAST_LEN, KV_LORA), 1.0),
        'cache_mla_krope': nrm(ks[5], (DEC_BATCH, L, PAST_LEN, MLA_ROPE), 1.0),
        'c': nrm(ks[6], (DEC_BATCH, D), 1.0),
        'c_ctx': nrm(ks[7], (D,), 1.0),
        'w_ada': nrm(ks[8], (L, D, N_MOD * D), 0.3 * D ** -0.5),
        'b_ada': nrm(ks[9], (L, N_MOD * D), 0.01),
        'norm_g': 1.0 + nrm(ks[10], (L, 3, D), 0.02),
        'w_ffn1_gate': nrm(ks[11], (L, D, F), D ** -0.5),
        'w_ffn1_up': nrm(ks[12], (L, D, F), D ** -0.5),
        'w_ffn1_down': nrm(ks[13], (L, F, D), F ** -0.5),
        'w_ffn2_gate': nrm(ks[14], (L, D, F), D ** -0.5),
        'w_ffn2_up': nrm(ks[15], (L, D, F), D ** -0.5),
        'w_ffn2_down': nrm(ks[16], (L, F, D), F ** -0.5),
        'w_in': nrm(ks[17], (L, D, IN_DIM), D ** -0.5),
        'conv_w': nrm(ks[18], (L, CONV_K, CONV_DIM), CONV_K ** -0.5),
        'conv_b': nrm(ks[19], (L, CONV_DIM), 0.01),
        'na_rpb': nrm(ks[20], (L, NA_HEADS, 2 * NA_WIN_R - 1, 2 * NA_WIN_C - 1), 0.1),
        'mla_qnorm': 1.0 + nrm(ks[21], (L, Q_LORA), 0.02),
        'w_uq': nrm(ks[22], (L, Q_LORA, MLA_HEADS * (MLA_NOPE + MLA_ROPE)), Q_LORA ** -0.5),
        'mla_kvnorm': 1.0 + nrm(ks[23], (L, KV_LORA), 0.02),
        'w_ukv': nrm(ks[24], (L, KV_LORA, MLA_HEADS * (MLA_NOPE + MLA_V)), KV_LORA ** -0.5),
        'w_conv_out': nrm(ks[25], (L, CONV_DIM, D), CONV_DIM ** -0.5),
        'w_na_out': nrm(ks[26], (L, NA_HEADS * NA_HD, D), (NA_HEADS * NA_HD) ** -0.5),
        'w_mla_out': nrm(ks[27], (L, MLA_HEADS * MLA_V, D), (MLA_HEADS * MLA_V) ** -0.5),
        'w_o': nrm(ks[28], (L, D, D), D ** -0.5),
        'final_g': 1.0 + nrm(ks[29], (D,), 0.02),
    }


def reference(x_prompt, x_sample, cache_na_k, cache_na_v, cache_mla_ckv, cache_mla_krope, c, c_ctx,
              w_ada, b_ada, norm_g, w_ffn1_gate, w_ffn1_up, w_ffn1_down, w_ffn2_gate, w_ffn2_up, w_ffn2_down,
              w_in, conv_w, conv_b, na_rpb, mla_qnorm, w_uq, mla_kvnorm, w_ukv,
              w_conv_out, w_na_out, w_mla_out, w_o, final_g):
    xp, xs = x_prompt, x_sample
    new_k, new_v, new_ckv, new_kr = [], [], [], []
    for l in range(DEPTH):
        p = dict(norm_g=norm_g[l], w_ffn1_gate=w_ffn1_gate[l], w_ffn1_up=w_ffn1_up[l], w_ffn1_down=w_ffn1_down[l],
                 w_ffn2_gate=w_ffn2_gate[l], w_ffn2_up=w_ffn2_up[l], w_ffn2_down=w_ffn2_down[l],
                 w_in=w_in[l], conv_w=conv_w[l], conv_b=conv_b[l], na_rpb=na_rpb[l],
                 mla_qnorm=mla_qnorm[l], w_uq=w_uq[l], mla_kvnorm=mla_kvnorm[l], w_ukv=w_ukv[l],
                 w_conv_out=w_conv_out[l], w_na_out=w_na_out[l], w_mla_out=w_mla_out[l], w_o=w_o[l])
        mod_ctx = (jax.nn.silu(c_ctx) @ w_ada[l] + b_ada[l]).reshape(1, 1, N_MOD, D_MODEL)
        mod_lat = (jax.nn.silu(c) @ w_ada[l] + b_ada[l]).reshape(-1, 1, N_MOD, D_MODEL)
        xp, (k_na, v_na, ckv, kr) = layer(xp, mod_ctx, p)
        xs, _ = layer(xs, mod_lat, p, (cache_na_k[:, l], cache_na_v[:, l], cache_mla_ckv[:, l], cache_mla_krope[:, l]))
        new_k.append(k_na)
        new_v.append(v_na)
        new_ckv.append(ckv)
        new_kr.append(kr)
    y_prompt = rmsnorm(xp, final_g)
    y_sample = rmsnorm(xs, final_g)
    return (y_prompt, y_sample, jnp.stack(new_k, axis=1), jnp.stack(new_v, axis=1),
            jnp.stack(new_ckv, axis=1), jnp.stack(new_kr, axis=1))
```

```cpp
#include <hip/hip_runtime.h>
#include <hip/hip_cooperative_groups.h>
#include <cstdio>
#include <cstdint>
namespace cg = cooperative_groups;

#define LAS __attribute__((address_space(3)))
typedef unsigned short bf16_t;
typedef short bf16x8 __attribute__((ext_vector_type(8)));
typedef short s16x4 __attribute__((ext_vector_type(4)));
typedef float f32x4 __attribute__((ext_vector_type(4)));
typedef float f32x2 __attribute__((ext_vector_type(2)));
typedef unsigned u32x4 __attribute__((ext_vector_type(4)));
typedef unsigned u32x2 __attribute__((ext_vector_type(2)));

constexpr int D = 1024, FF = 2816, M = 16384, MP = 8192, NL = 2;
constexpr int UN = 6656;
constexpr int UC_BG = 0, UC_CG = 512, UC_XC = 1024, UC_QNA = 1536, UC_KNA = 2048, UC_VNA = 2560, UC_CQ = 3072, UC_CKV = 3328, UC_KR = 3456, UC_G = 3584;
constexpr int UC_QM = 0;
constexpr int UC_ONA = UC_QNA;
constexpr int UC_OM = UC_XC;
constexpr int UC_YC = UC_CQ;
constexpr int UC_Z = UC_KNA;
constexpr float EPS = 1e-6f;
constexpr float LOG2E = 1.4426950408889634f;

constexpr size_t MiB = 1u << 20;
constexpr size_t WS_MOD = 0;
constexpr size_t WS_ROPE = 768 * 1024;
constexpr size_t WS_TAB = 800 * 1024;
constexpr size_t WS_NG = 808 * 1024;
constexpr size_t WS_BAR = 832 * 1024;
constexpr size_t WS_W = 1 * MiB;
constexpr size_t WS_H = 53 * MiB;
constexpr size_t WS_U = 85 * MiB;
constexpr size_t WS_KVX = 293 * MiB;
constexpr size_t WS_CK = 329 * MiB;
constexpr size_t WS_CV = 333 * MiB;
constexpr size_t WS_SS = 337 * MiB;
constexpr size_t WS_CNT = 337 * MiB + 512 * 1024;
constexpr size_t WS_FG = 776 * 1024;
constexpr size_t WS_SW = 338 * MiB;
constexpr size_t WS_END = 340 * MiB;
constexpr size_t WO_GU1 = 0, WO_D1 = WO_GU1 + 5632 * 1024, WO_IN = WO_D1 + 1024 * 2816, WO_UQ = WO_IN + (size_t)UN * 1024, WO_UKV = WO_UQ + 768 * 256,
                 WO_C = WO_UKV + 1024 * 128, WO_N = WO_C + 1024 * 512, WO_M = WO_N + 1024 * 512, WO_O = WO_M + 1024 * 512, WO_GU2 = WO_O + 1024 * 1024,
                 WO_D2 = WO_GU2 + 5632 * 1024, WO_END = WO_D2 + 1024 * 2816;
static_assert(WO_END * 2 <= 52 * MiB, "weights fit");
constexpr size_t HO_YC = 0, HO_CQN = 16 * MiB, HO_CKVN = 24 * MiB, HO_KR = 24 * MiB + 4718592;
static_assert(HO_KR + 18432 * 32 * 2 <= 32 * MiB, "H region");
constexpr size_t OUT_YS = 8388608, OUT_NK = 16777216, OUT_NV = 25165824, OUT_CKV = 33554432, OUT_KR = 35651584;

constexpr int LDS_BYTES = 147456;
#ifndef PROBE_MASK
#define PROBE_MASK 0
#endif
#ifndef PROBE_SYNC
#define PROBE_SYNC 0
#endif

__device__ __forceinline__ unsigned cvt_pk_bf16(float lo, float hi) { unsigned r; asm volatile("v_cvt_pk_bf16_f32 %0, %1, %2" : "=v"(r) : "v"(lo), "v"(hi)); return r; }
__device__ __forceinline__ float bf_lo(unsigned x) { return __builtin_bit_cast(float, x << 16); }
__device__ __forceinline__ float bf_hi(unsigned x) { return __builtin_bit_cast(float, x & 0xffff0000u); }
__device__ __forceinline__ float bf1(bf16_t x) { return __builtin_bit_cast(float, (unsigned)x << 16); }
__device__ __forceinline__ bf16_t f2bf(float f) { return (bf16_t)(cvt_pk_bf16(f, 0.f) & 0xffffu); }
__device__ __forceinline__ float shfl_x(float v, int mask, int lane) { return __builtin_bit_cast(float, __builtin_amdgcn_ds_bpermute((lane ^ mask) << 2, __builtin_bit_cast(int, v))); }
__device__ __forceinline__ float wave_sum(float v, int lane) {
#pragma unroll
    for (int o = 1; o < 64; o <<= 1) v += shfl_x(v, o, lane);
    return v;
}
__device__ __forceinline__ float sigmoidf_(float x) { return __builtin_amdgcn_rcpf(1.f + __builtin_amdgcn_exp2f(-x * LOG2E)); }
__device__ __forceinline__ int lane_id_v() { int x; asm volatile("v_mbcnt_lo_u32_b32 %0, -1, 0\n\tv_mbcnt_hi_u32_b32 %0, -1, %0" : "=&v"(x)); return x; }
__device__ __forceinline__ int mod_index(int row) { return row < MP ? 0 : 1 + ((row - MP) >> 10); }

namespace pg8 {
constexpr int BM = 256, BK = 64, HALF = 128, HTB = HALF * BK * 2, STAGE_BYTES = 8 * HTB, NXCD = 8, WGM = 8;
__host__ __device__ __forceinline__ int lds_byte(int r, int c) { const int st = (r >> 4) * 2 + (c >> 5), rr = r & 15, cc = c & 31, ob = rr * 64 + cc * 2; return st * 1024 + (ob ^ (((ob >> 9) & 1) << 5)); }
__host__ __device__ __forceinline__ void stage_rc(int b, int& R, int& C) { const int st = b / 1024, sb = b % 1024, swz = sb ^ (((sb >> 9) & 1) << 5); R = (st >> 1) * 16 + swz / 64; C = (st & 1) * 32 + (swz % 64) / 2; }
__host__ __device__ __forceinline__ int perm32(int rho) { const int n = rho >> 4, i = rho & 15; return 8 * (i >> 2) + 4 * n + (i & 3); }
struct Unit { int pm, pn, seg; };
struct Gemm { const bf16_t* A; const bf16_t* Bt; int lda, ldb, K; };
struct StaticOrder {
    int nM, nN, nwg, G, c, segs;
    __device__ void init(int M_, int N_, int G_, int c_, int segs_ = 1) { nM = M_ / BM; nN = N_ / BM; nwg = nM * nN; G = G_; c = c_; segs = segs_; }
    __device__ bool next(int i, Unit& u) const {
        const int ir = i / segs; u.seg = i - ir * segs;
        const long L = (long)ir * G + c; if (L >= nwg) return false;
        int wgid = (int)L; { const int q = nwg / NXCD, r = nwg % NXCD, xcd = wgid % NXCD, off = wgid / NXCD; wgid = (xcd < r ? xcd * (q + 1) : r * (q + 1) + (xcd - r) * q) + off; }
        const int nig = WGM * nN, gid = wgid / nig, fm = gid * WGM, gsz = (nM - fm) < WGM ? (nM - fm) : WGM;
        u.pm = fm + ((wgid % nig) % gsz); u.pn = (wgid % nig) / gsz; return true;
    }
};
template <class Epi, bool SEG3 = false>
__device__ __forceinline__ void gemm_phase(LAS unsigned char* lds, const int tid, const Gemm g, const StaticOrder& S, const Epi& E) {
    const int wid = __builtin_amdgcn_readfirstlane(tid >> 6), lane = tid & 63, wr = wid >> 2, wc = wid & 3, fr = lane & 15, fq = lane >> 4;
    const int K = g.K, nt = K / BK;
    unsigned voffA, voffB;
    { int R, C; stage_rc(tid * 16, R, C); const int Rb = (R & ~31) + perm32(R & 31);
      voffA = (unsigned)(R * g.lda + C) * 2u; voffB = (unsigned)(Rb * g.ldb + C) * 2u; }
    const unsigned q64voffA = 64u * (unsigned)g.lda * 2u, q64voffB = 64u * (unsigned)g.ldb * 2u;
    const unsigned kstep = (unsigned)(BK * 2);
    const unsigned hstepA = (unsigned)HALF * g.lda * 2u, hstepB = (unsigned)HALF * g.ldb * 2u;
    const unsigned tstepA = 2u * hstepA, tstepB = 2u * hstepB;
    const unsigned ldsw = (unsigned)wid * 1024u;
    const int aoff = lds_byte(wr * 64 + fr, fq * 8), boff = lds_byte(wc * 32 + fr, fq * 8);
#define PG8_SA(b, h) (((b) * 2 + (h)) * HTB)
#define PG8_SB(b, h) ((4 + (b) * 2 + (h)) * HTB)
#define PG8_STAGE(bufoff, gbase, voff) do { \
        __builtin_amdgcn_global_load_lds((const unsigned*)((const char*)(gbase) + (voff)), (LAS unsigned*)(lds + (bufoff) + ldsw), 16, 0, 0); \
        __builtin_amdgcn_global_load_lds((const unsigned*)((const char*)(gbase) + q64##voff + (voff)), (LAS unsigned*)(lds + (bufoff) + ldsw + 8192), 16, 0, 0); } while (0)
#define PG8_LDA(dst, b, h) do { _Pragma("unroll") for (int m = 0; m < 4; ++m) _Pragma("unroll") for (int k = 0; k < 2; ++k) dst[m][k] = *(const LAS bf16x8*)(lds + PG8_SA(b, h) + aoff + m * 2048 + k * 1024); } while (0)
#define PG8_LDB(dst, b, h) do { _Pragma("unroll") for (int n = 0; n < 2; ++n) _Pragma("unroll") for (int k = 0; k < 2; ++k) dst[n][k] = *(const LAS bf16x8*)(lds + PG8_SB(b, h) + boff + n * 2048 + k * 1024); } while (0)
#define PG8_MMA(ai, bj, At, Bt) do { __builtin_amdgcn_s_setprio(1); _Pragma("unroll") for (int m = 0; m < 4; ++m) _Pragma("unroll") for (int n = 0; n < 2; ++n) _Pragma("unroll") for (int k = 0; k < 2; ++k) \
        acc[ai][bj][m][n] = __builtin_amdgcn_mfma_f32_16x16x32_bf16(Bt[n][k], At[m][k], acc[ai][bj][m][n], 0, 0, 0); __builtin_amdgcn_s_setprio(0); } while (0)
#define PG8_WAIT_V(n) asm volatile("s_waitcnt vmcnt(" #n ")" ::: "memory")
#define PG8_WAIT_L(n) asm volatile("s_waitcnt lgkmcnt(" #n ")" ::: "memory")
#define PG8_BAR __builtin_amdgcn_s_barrier()
#define PG8_SCHED __builtin_amdgcn_sched_barrier(0)
    Unit cur, nxt; int ui = 0;
    if (!S.next(0, cur)) return;
    f32x4 acc[2][2][4][2];
#pragma unroll
    for (int a = 0; a < 2; ++a)
#pragma unroll
        for (int b = 0; b < 2; ++b)
#pragma unroll
            for (int m = 0; m < 4; ++m)
#pragma unroll
                for (int n = 0; n < 2; ++n) acc[a][b][m][n] = (f32x4){0.f, 0.f, 0.f, 0.f};
    bf16x8 At[4][2], B0[2][2], B1[2][2];
    if constexpr (Epi::PF) E.prefetch(lds, cur, 0, wid, lane);
    unsigned sgA = 0u, sgB = 0u; if constexpr (SEG3) { sgA = Epi::segA(cur.seg); sgB = Epi::segB(cur.seg); }
    const char* cA = (const char*)g.A + (size_t)cur.pm * tstepA + sgA; const char* cB = (const char*)g.Bt + (size_t)cur.pn * tstepB + sgB;
    PG8_STAGE(PG8_SB(0, 0), cB, voffB); PG8_STAGE(PG8_SB(0, 1), cB + hstepB, voffB); PG8_STAGE(PG8_SA(0, 0), cA, voffA); PG8_STAGE(PG8_SA(0, 1), cA + hstepA, voffA);
    if (wr == 1) PG8_BAR;
    PG8_WAIT_V(2); PG8_BAR;
    PG8_STAGE(PG8_SB(1, 0), cB + kstep, voffB); PG8_STAGE(PG8_SA(1, 0), cA + kstep, voffA); PG8_STAGE(PG8_SB(1, 1), cB + hstepB + kstep, voffB);
    PG8_WAIT_V(6); PG8_BAR;
    for (;;) {
        const bool has_next = S.next(ui + 1, nxt);
        unsigned ngA = 0u, ngB = 0u; if constexpr (SEG3) { if (has_next) { ngA = Epi::segA(nxt.seg); ngB = Epi::segB(nxt.seg); } }
        const char* nA = has_next ? (const char*)g.A + (size_t)nxt.pm * tstepA + ngA : cA; const char* nB = has_next ? (const char*)g.Bt + (size_t)nxt.pn * tstepB + ngB : cB;
        for (int t = 0; t < nt; t += 2) {
            const bool last = (t == nt - 2);
            const char* a1 = cA + (size_t)(t + 1) * kstep;
            const char* a2 = last ? nA : cA + (size_t)(t + 2) * kstep; const char* b2 = last ? nB : cB + (size_t)(t + 2) * kstep;
            const char* a3 = a2 + kstep; const char* b3 = b2 + kstep;
            PG8_LDB(B0, 0, 0); PG8_LDB(B1, 0, 1); PG8_SCHED; PG8_LDA(At, 0, 0); PG8_STAGE(PG8_SA(1, 1), a1 + hstepA, voffA);
            PG8_WAIT_V(8); PG8_WAIT_L(0); PG8_BAR; PG8_MMA(0, 0, At, B0); PG8_MMA(0, 1, At, B1); PG8_BAR; PG8_SCHED;
            PG8_LDA(At, 0, 1); PG8_STAGE(PG8_SB(0, 0), b2, voffB); PG8_STAGE(PG8_SB(0, 1), b2 + hstepB, voffB); PG8_STAGE(PG8_SA(0, 0), a2, voffA);
            PG8_WAIT_V(8); PG8_WAIT_L(0); PG8_BAR; PG8_MMA(1, 0, At, B0); PG8_MMA(1, 1, At, B1); PG8_BAR; PG8_SCHED;
            PG8_LDB(B0, 1, 0); PG8_LDB(B1, 1, 1); PG8_SCHED; PG8_LDA(At, 1, 0); PG8_STAGE(PG8_SA(0, 1), a2 + hstepA, voffA);
            PG8_WAIT_V(8); PG8_WAIT_L(0); PG8_BAR; PG8_MMA(0, 0, At, B0); PG8_MMA(0, 1, At, B1); PG8_BAR; PG8_SCHED;
            PG8_LDA(At, 1, 1); PG8_STAGE(PG8_SB(1, 0), b3, voffB); PG8_STAGE(PG8_SB(1, 1), b3 + hstepB, voffB); PG8_STAGE(PG8_SA(1, 0), a3, voffA);
            PG8_WAIT_V(8); PG8_WAIT_L(0); PG8_BAR; PG8_MMA(1, 0, At, B0); PG8_MMA(1, 1, At, B1); PG8_BAR; PG8_SCHED;
        }
        if (wr == 0) PG8_BAR;
        { int t_e = lane_id_v(); asm volatile("" : "+v"(t_e));
          if constexpr (Epi::PF) { if (has_next) E.prefetch(lds, nxt, (ui + 1) % 3, wid, lane);
              E(acc, cur, wr, wc, t_e & 15, (t_e >> 4) & 3, lds, ui % 3); }
          else E(acc, cur, wr, wc, t_e & 15, (t_e >> 4) & 3); }
        if (!has_next) break;
        if (!SEG3 || cur.seg == 2) {
#pragma unroll
        for (int a = 0; a < 2; ++a)
#pragma unroll
            for (int b = 0; b < 2; ++b)
#pragma unroll
                for (int m = 0; m < 4; ++m)
#pragma unroll
                    for (int n = 0; n < 2; ++n) acc[a][b][m][n] = (f32x4){0.f, 0.f, 0.f, 0.f};
        }
        cur = nxt; cA = nA; cB = nB; ++ui;
        if (wr == 1) PG8_BAR;
    }
    PG8_WAIT_V(0);
    PG8_BAR;
#undef PG8_SA
#undef PG8_SB
#undef PG8_STAGE
#undef PG8_LDA
#undef PG8_LDB
#undef PG8_MMA
#undef PG8_WAIT_V
#undef PG8_WAIT_L
#undef PG8_BAR
#undef PG8_SCHED
}
}
using pg8::Unit;
typedef f32x4 AccT[2][2][4][2];

constexpr int EPB_OFF = 131072;
struct EpiSwiglu {
    static constexpr bool PF = true;
    bf16_t* O; const float* ss; const float* sw;
    __device__ __forceinline__ void prefetch(LAS unsigned char* lds, const Unit& u, int slot, int wid, int lane) const {
        const float* src = wid < 4 ? ss + u.pm * 256 + wid * 64 + lane : sw + (size_t)mod_index(u.pm * 256) * 6656 + u.pn * 256 + (wid - 4) * 64 + lane;
        __builtin_amdgcn_global_load_lds((const unsigned*)src, (LAS unsigned*)(lds + EPB_OFF + slot * 2048 + wid * 256), 4, 0, 0);
    }
    __device__ __forceinline__ void operator()(AccT& acc, const Unit& u, int wr, int wc, int fr, int fq, LAS unsigned char* lds, int slot) const {
        const int row0 = u.pm * 256 + wr * 64 + fr, col0 = u.pn * 128 + wc * 32 + fq * 8;
        const LAS float* eb = (const LAS float*)(lds + EPB_OFF + slot * 2048);
        const LAS float* swp = eb + 256 + wc * 32 + fq * 8;
        f32x4 sg[2], su[2];
#pragma unroll
        for (int n = 0; n < 2; ++n) { sg[n] = *(const LAS f32x4*)(swp + n * 4); su[n] = *(const LAS f32x4*)(swp + 128 + n * 4); }
#pragma unroll
        for (int ai = 0; ai < 2; ++ai)
#pragma unroll
            for (int m = 0; m < 4; ++m) {
                const int row = row0 + ai * 128 + m * 16;
                const float rstd = rsqrtf(eb[ai * 128 + wr * 64 + m * 16 + fr] * (1.f / D) + EPS);
                float r[8];
#pragma unroll
                for (int n = 0; n < 2; ++n)
#pragma unroll
                    for (int j = 0; j < 4; ++j) { const float gt = rstd * acc[ai][0][m][n][j] + sg[n][j], up = rstd * acc[ai][1][m][n][j] + su[n][j]; r[n * 4 + j] = gt * sigmoidf_(gt) * up; }
                u32x4 w; w.x = cvt_pk_bf16(r[0], r[1]); w.y = cvt_pk_bf16(r[2], r[3]); w.z = cvt_pk_bf16(r[4], r[5]); w.w = cvt_pk_bf16(r[6], r[7]);
                *(u32x4*)(O + (size_t)row * FF + col0) = w;
            }
    }
};
template <bool FIN> struct EpiResidT {
    static constexpr bool PF = false;
    float* X; unsigned char* ws; float coef;
    int gate_off;
    int ss_slot;
    int gn_off;
    int sc_off;
    __device__ __forceinline__ void operator()(AccT& acc, const Unit& u, int wr, int wc, int fr, int fq) const {
        const int row0 = u.pm * 256 + wr * 64 + fr, col0 = u.pn * 256 + wc * 32 + fq * 8, lane = fq * 16 + fr;
        const int mb = mod_index(u.pm * 256);
        constexpr bool fin = FIN;
        const float* MODp = (const float*)(ws + WS_MOD);
        const float* gp = MODp + gate_off + (size_t)mb * 9216 + col0;
        float* ss = (float*)(ws + WS_SS) + (size_t)ss_slot * M;
        bf16_t* Hout = gn_off >= 0 ? (bf16_t*)(ws + WS_H) : nullptr;
        const float* gn = (const float*)(ws + WS_NG) + (gn_off >= 0 ? gn_off : 0);
        const float* scn = MODp + sc_off;
        f32x4 gv[2][2], av[2][2];
#pragma unroll
        for (int bj = 0; bj < 2; ++bj)
#pragma unroll
            for (int n = 0; n < 2; ++n) {
                gv[bj][n] = *(const f32x4*)(gp + bj * 128 + n * 4) * coef;
                av[bj][n] = (f32x4){0.f, 0.f, 0.f, 0.f};
                if (Hout) av[bj][n] = *(const f32x4*)(gn + col0 + bj * 128 + n * 4) * (*(const f32x4*)(scn + (size_t)mb * 9216 + col0 + bj * 128 + n * 4) + 1.f);
            }
#pragma unroll
        for (int ai = 0; ai < 2; ++ai) {
#pragma unroll
          for (int mp = 0; mp < 2; ++mp) {
            f32x4 xin[4][2][2];
#pragma unroll
            for (int m = 2 * mp; m < 2 * mp + 2; ++m)
#pragma unroll
                for (int bj = 0; bj < 2; ++bj)
#pragma unroll
                    for (int n = 0; n < 2; ++n) xin[m][bj][n] = *(const f32x4*)(X + (size_t)(row0 + ai * 128 + m * 16) * D + col0 + bj * 128 + n * 4);
#pragma unroll
            for (int m = 2 * mp; m < 2 * mp + 2; ++m) {
                const int row = row0 + ai * 128 + m * 16;
                float* xr = X + (size_t)row * D + col0;
                float ssum = 0.f;
#pragma unroll
                for (int bj = 0; bj < 2; ++bj) {
                    f32x4 xv[2];
#pragma unroll
                    for (int n = 0; n < 2; ++n) { f32x4* p = (f32x4*)(xr + bj * 128 + n * 4); f32x4 x = xin[m][bj][n]; x = x + gv[bj][n] * acc[ai][bj][m][n]; if constexpr (FIN) acc[ai][bj][m][n] = x; else *p = x; xv[n] = x;
                        ssum += (x[0] * x[0] + x[1] * x[1]) + (x[2] * x[2] + x[3] * x[3]); }
                    if (Hout) { const f32x4 h0 = xv[0] * av[bj][0], h1 = xv[1] * av[bj][1];
                        u32x4 w; w.x = cvt_pk_bf16(h0[0], h0[1]); w.y = cvt_pk_bf16(h0[2], h0[3]); w.z = cvt_pk_bf16(h1[0], h1[1]); w.w = cvt_pk_bf16(h1[2], h1[3]);
                        *(u32x4*)(Hout + (size_t)row * D + col0 + bj * 128) = w; }
                }
                ssum += shfl_x(ssum, 16, lane); ssum += shfl_x(ssum, 32, lane);
                if (fq == 0) unsafeAtomicAdd(ss + row, ssum);
            }
          }
        }
        if constexpr (FIN) {
            asm volatile("s_waitcnt vmcnt(0)" ::: "memory");
            __syncthreads();
            if (wr == 0 && wc == 0 && lane == 0) {
                unsigned* cnt = (unsigned*)(ws + WS_CNT) + u.pm * 64;
                (void)__hip_atomic_fetch_add(cnt, 1u, __ATOMIC_RELEASE, __HIP_MEMORY_SCOPE_AGENT);
                unsigned sp = 0u;
                while (__hip_atomic_load(cnt, __ATOMIC_ACQUIRE, __HIP_MEMORY_SCOPE_AGENT) < 4u && sp < (1u << 22)) { __builtin_amdgcn_s_sleep(1); ++sp; }
            }
            __syncthreads();
            const float* fg = (const float*)(ws + WS_FG) + col0;
            f32x4 fv[2][2];
#pragma unroll
            for (int bj = 0; bj < 2; ++bj)
#pragma unroll
                for (int n = 0; n < 2; ++n) fv[bj][n] = *(const f32x4*)(fg + bj * 128 + n * 4);
            float rsv[2][4];
#pragma unroll
            for (int ai = 0; ai < 2; ++ai)
#pragma unroll
                for (int m = 0; m < 4; ++m) rsv[ai][m] = __hip_atomic_load(ss + row0 + ai * 128 + m * 16, __ATOMIC_RELAXED, __HIP_MEMORY_SCOPE_AGENT);
#pragma unroll
            for (int ai = 0; ai < 2; ++ai)
#pragma unroll
                for (int m = 0; m < 4; ++m) {
                    const int row = row0 + ai * 128 + m * 16;
                    const float rstd = rsqrtf(rsv[ai][m] * (1.f / D) + EPS);
                    float* xr = X + (size_t)row * D + col0;
#pragma unroll
                    for (int bj = 0; bj < 2; ++bj)
#pragma unroll
                        for (int n = 0; n < 2; ++n) *(f32x4*)(xr + bj * 128 + n * 4) = acc[ai][bj][m][n] * rstd * fv[bj][n];
                }
        }
    }
};
struct EpiIn {
    static constexpr bool PF = true;
    bf16_t* U; float* out; int l; const float* ss; const float* sw;
    __device__ __forceinline__ void prefetch(LAS unsigned char* lds, const Unit& u, int slot, int wid, int lane) const {
        const float* src = wid < 4 ? ss + u.pm * 256 + wid * 64 + lane : sw + (size_t)mod_index(u.pm * 256) * 6656 + u.pn * 256 + (wid - 4) * 64 + lane;
        __builtin_amdgcn_global_load_lds((const unsigned*)src, (LAS unsigned*)(lds + EPB_OFF + slot * 2048 + wid * 256), 4, 0, 0);
    }
    __device__ __forceinline__ void operator()(AccT& acc, const Unit& u, int wr, int wc, int fr, int fq, LAS unsigned char* lds, int slot) const {
        const int row0 = u.pm * 256 + wr * 64 + fr, col0 = u.pn * 256 + wc * 32 + fq * 8;
        const LAS float* eb = (const LAS float*)(lds + EPB_OFF + slot * 2048);
        const LAS float* swp = eb + 256 + wc * 32 + fq * 8;
        f32x4 sv[2][2];
#pragma unroll
        for (int bj = 0; bj < 2; ++bj)
#pragma unroll
            for (int n = 0; n < 2; ++n) sv[bj][n] = *(const LAS f32x4*)(swp + bj * 128 + n * 4);
        const bool prm = u.pm < 32;
        const int b = u.pm;
        const bool kv = prm && u.pn >= 8 && u.pn < 12, kr = prm && u.pn == 13 && wc == 0;
        float* cbase = out + (u.pn < 10 ? OUT_NK : OUT_NV);
        const int hq = (u.pn & 1) * 4;
#pragma unroll
        for (int ai = 0; ai < 2; ++ai)
#pragma unroll
            for (int m = 0; m < 4; ++m) {
                const int row = row0 + ai * 128 + m * 16, s = ai * 128 + wr * 64 + m * 16 + fr;
                const float rstd = rsqrtf(eb[s] * (1.f / D) + EPS);
#pragma unroll
                for (int bj = 0; bj < 2; ++bj) {
                    const f32x4 v0 = acc[ai][bj][m][0] * rstd + sv[bj][0], v1 = acc[ai][bj][m][1] * rstd + sv[bj][1];
                    u32x4 w; w.x = cvt_pk_bf16(v0[0], v0[1]); w.y = cvt_pk_bf16(v0[2], v0[3]); w.z = cvt_pk_bf16(v1[0], v1[1]); w.w = cvt_pk_bf16(v1[2], v1[3]);
                    *(u32x4*)(U + (size_t)row * UN + col0 + bj * 128) = w;
                    if (kv) { const int h = hq + bj * 2 + (wc >> 1), d0 = (wc & 1) * 32 + fq * 8;
                        float* hb = cbase + ((size_t)((b * 2 + l) * 8 + h) * 256 + s) * 64 + d0;
                        *(f32x4*)hb = v0; *(f32x4*)(hb + 4) = v1; }
                    if (kr && bj == 1) { float* kb = out + OUT_KR + ((size_t)(b * 2 + l) * 256 + s) * 32 + fq * 8;
                        *(f32x4*)kb = v0; *(f32x4*)(kb + 4) = v1; }
                }
            }
    }
};
struct EpiQ {
    static constexpr bool PF = false;
    bf16_t* U; const f32x2* rope;
    __device__ __forceinline__ void operator()(AccT& acc, const Unit& u, int wr, int wc, int fr, int fq) const {
        const int row0 = u.pm * 256 + wr * 64 + fr, col0 = u.pn * 256 + wc * 32 + fq * 8;
        const bool sample = u.pm >= 32;
#pragma unroll
        for (int ai = 0; ai < 2; ++ai)
#pragma unroll
            for (int m = 0; m < 4; ++m) {
                const int row = row0 + ai * 128 + m * 16;
                const int s = (row - MP) & 1023, grow = s >> 6, gcol = s & 63;
#pragma unroll
                for (int bj = 0; bj < 2; ++bj) {
                    float v[8];
#pragma unroll
                    for (int n = 0; n < 2; ++n)
#pragma unroll
                        for (int j = 0; j < 4; ++j) v[n * 4 + j] = acc[ai][bj][m][n][j];
                    if (sample) {
                        const int cb = (col0 + bj * 128) % 96;
                        const bool isr = cb >= 64;
                        const int pos = (cb >= 80) ? gcol : grow;
                        const bool second = ((cb >> 3) & 1) != 0;
#pragma unroll
                        for (int i = 0; i < 8; ++i) {
                            const float pr = shfl_x(v[i], 16, fq * 16 + fr);
                            const f32x2 cs = rope[pos * 8 + i];
                            const float o = second ? (pr * cs.y + v[i] * cs.x) : (v[i] * cs.x - pr * cs.y);
                            v[i] = isr ? o : v[i];
                        }
                    }
                    u32x4 w; w.x = cvt_pk_bf16(v[0], v[1]); w.y = cvt_pk_bf16(v[2], v[3]); w.z = cvt_pk_bf16(v[4], v[5]); w.w = cvt_pk_bf16(v[6], v[7]);
                    *(u32x4*)(U + (size_t)row * UN + UC_QM + col0 + bj * 128) = w;
                }
            }
    }
};
struct EpiPlain {
    static constexpr bool PF = false;
    bf16_t* O; int ldc;
    __device__ __forceinline__ void operator()(AccT& acc, const Unit& u, int wr, int wc, int fr, int fq) const {
        const int row0 = u.pm * 256 + wr * 64 + fr, col0 = u.pn * 256 + wc * 32 + fq * 8;
#pragma unroll
        for (int ai = 0; ai < 2; ++ai)
#pragma unroll
            for (int m = 0; m < 4; ++m)
#pragma unroll
                for (int bj = 0; bj < 2; ++bj) {
                    const f32x4 v0 = acc[ai][bj][m][0], v1 = acc[ai][bj][m][1];
                    u32x4 w; w.x = cvt_pk_bf16(v0[0], v0[1]); w.y = cvt_pk_bf16(v0[2], v0[3]); w.z = cvt_pk_bf16(v1[0], v1[1]); w.w = cvt_pk_bf16(v1[2], v1[3]);
                    *(u32x4*)(O + (size_t)(row0 + ai * 128 + m * 16) * ldc + col0 + bj * 128) = w;
                }
    }
};
struct EpiZ3 {
    static constexpr bool PF = false;
    bf16_t* U;
    static __device__ __forceinline__ unsigned segA(int seg) { return (unsigned)(seg == 0 ? UC_YC : (seg == 1 ? UC_ONA : UC_OM)) * 2u; }
    static __device__ __forceinline__ unsigned segB(int seg) { return (unsigned)seg * (1024u * 512u * 2u); }
    static __device__ __forceinline__ float en(float x) { return __builtin_amdgcn_exp2f(-fminf(fmaxf(x, -30.f), 30.f) * LOG2E); }
    __device__ __forceinline__ void operator()(AccT& acc, const Unit& u, int wr, int wc, int fr, int fq) const {
        const int row0 = u.pm * 256 + wr * 64 + fr, col0 = u.pn * 256 + wc * 32 + fq * 8;
        const int seg = u.seg;
        const int sga = (seg < 2 ? seg : 2) * 1024, sgb = (seg < 2 ? seg + 1 : 2) * 1024;
#pragma unroll
        for (int ai = 0; ai < 2; ++ai)
#pragma unroll
          for (int mp = 0; mp < 2; ++mp) {
            u32x4 gA[2][2], gB[2][2];
#pragma unroll
            for (int mm = 0; mm < 2; ++mm)
#pragma unroll
                for (int bj = 0; bj < 2; ++bj) {
                    const bf16_t* ur_ = U + (size_t)(row0 + ai * 128 + (2 * mp + mm) * 16) * UN + UC_G + col0 + bj * 128;
                    gA[mm][bj] = *(const u32x4*)(ur_ + sga); gB[mm][bj] = *(const u32x4*)(ur_ + sgb);
                }
#pragma unroll
            for (int mm = 0; mm < 2; ++mm) {
                const int m = 2 * mp + mm;
                bf16_t* ur = U + (size_t)(row0 + ai * 128 + m * 16) * UN;
#pragma unroll
                for (int bj = 0; bj < 2; ++bj) {
                    const int col = col0 + bj * 128;
                    float f[8];
                    if (seg < 2) {
                        const u32x4 ga = gA[mm][bj], gb = gB[mm][bj];
#pragma unroll
                        for (int q = 0; q < 4; ++q) {
                            f[2 * q] = (1.f + en(bf_lo(gb[q]))) * __builtin_amdgcn_rcpf(1.f + en(bf_lo(ga[q])));
                            f[2 * q + 1] = (1.f + en(bf_hi(gb[q]))) * __builtin_amdgcn_rcpf(1.f + en(bf_hi(ga[q])));
                        }
                    } else {
                        const u32x4 ga = gA[mm][bj];
#pragma unroll
                        for (int q = 0; q < 4; ++q) { f[2 * q] = __builtin_amdgcn_rcpf(1.f + en(bf_lo(ga[q]))); f[2 * q + 1] = __builtin_amdgcn_rcpf(1.f + en(bf_hi(ga[q]))); }
                    }
#pragma unroll
                    for (int n = 0; n < 2; ++n)
#pragma unroll
                        for (int j = 0; j < 4; ++j) acc[ai][bj][m][n][j] *= f[n * 4 + j];
                    if (seg == 2) {
                        const f32x4 v0 = acc[ai][bj][m][0], v1 = acc[ai][bj][m][1];
                        u32x4 w; w.x = cvt_pk_bf16(v0[0], v0[1]); w.y = cvt_pk_bf16(v0[2], v0[3]); w.z = cvt_pk_bf16(v1[0], v1[1]); w.w = cvt_pk_bf16(v1[2], v1[3]);
                        *(u32x4*)(ur + UC_Z + col) = w;
                    }
                }
            }
          }
    }
};

struct AttnSeg { unsigned k1, k2, v; int ldk1, ldk2, ldv, nkeys; };

template <int DQK, bool NAL>
__device__ __forceinline__ void attn_unit(LAS unsigned char* lds, const int tid, const unsigned char* wsb, const bf16_t* Q, int ldq, bf16_t* O, int ldo, const AttnSeg s0, const AttnSeg s1,
                                          float sc_log2, int qrow0, int rb0, const float* rpb_h) {
    constexpr int KSTR = (DQK + 8) * 2, VSTR = 144, CPR = DQK / 8, NKS = DQK / 32, NQ = 2;
    const int w = __builtin_amdgcn_readfirstlane(tid >> 6), lane = tid & 63, fr = lane & 15, fq = lane >> 4;
    LAS float* biasL = (LAS float*)(lds + 49152);
    __syncthreads();
    if (NAL) { for (int i = tid; i < 15 * 31; i += 512) biasL[i] = rpb_h[i] * LOG2E; }
    bf16x8 qf[NQ][NKS];
#pragma unroll
    for (int qi = 0; qi < NQ; ++qi) { const bf16_t* qr = Q + (size_t)(32 * w + 16 * qi + fr) * ldq + fq * 8;
#pragma unroll
      for (int ks = 0; ks < NKS; ++ks) qf[qi][ks] = *(const bf16x8*)(qr + ks * 32); }
    f32x4 ot[NQ][4];
    float mrun[NQ], lsum[NQ];
#pragma unroll
    for (int qi = 0; qi < NQ; ++qi) { unsigned ni_ = 0xff800000u, z_ = 0u; asm volatile("" : "+v"(ni_), "+v"(z_));
        mrun[qi] = __builtin_bit_cast(float, ni_); lsum[qi] = __builtin_bit_cast(float, z_);
#pragma unroll
        for (int c = 0; c < 4; ++c) ot[qi][c] = (f32x4){0.f, 0.f, 0.f, 0.f}; }
    const int T0 = s0.nkeys >> 6, T = T0 + (s1.nkeys >> 6);
    const int kr0 = tid / CPR, kc0 = tid % CPR;
    const int kr1 = (tid + 512) / CPR, kc1 = (tid + 512) % CPR;
    const bool has2 = (DQK == 96) && (tid < 256);
    const int vr = tid >> 3, vc = tid & 7;
    u32x4 rk0[4], rk1[4], rv[4];
#pragma unroll
    for (int s_ = 0; s_ < 4; ++s_) rk1[s_] = (u32x4){0u, 0u, 0u, 0u};
    const unsigned pa0 = (kc0 < 8) ? s0.k1 + (unsigned)(kr0 * s0.ldk1 + kc0 * 8) * 2u : s0.k2 + (unsigned)(kr0 * s0.ldk2 + (kc0 - 8) * 8) * 2u;
    const unsigned pb0 = (kc0 < 8) ? s1.k1 + (unsigned)(kr0 * s1.ldk1 + kc0 * 8) * 2u : s1.k2 + (unsigned)(kr0 * s1.ldk2 + (kc0 - 8) * 8) * 2u;
    const unsigned sa0 = (unsigned)((kc0 < 8) ? s0.ldk1 : s0.ldk2) * 128u, sb0 = (unsigned)((kc0 < 8) ? s1.ldk1 : s1.ldk2) * 128u;
    const unsigned pa1 = (kc1 < 8) ? s0.k1 + (unsigned)(kr1 * s0.ldk1 + kc1 * 8) * 2u : s0.k2 + (unsigned)(kr1 * s0.ldk2 + (kc1 - 8) * 8) * 2u;
    const unsigned pb1 = (kc1 < 8) ? s1.k1 + (unsigned)(kr1 * s1.ldk1 + kc1 * 8) * 2u : s1.k2 + (unsigned)(kr1 * s1.ldk2 + (kc1 - 8) * 8) * 2u;
    const unsigned sa1 = (unsigned)((kc1 < 8) ? s0.ldk1 : s0.ldk2) * 128u, sb1 = (unsigned)((kc1 < 8) ? s1.ldk1 : s1.ldk2) * 128u;
    const unsigned pav = s0.v + (unsigned)(vr * s0.ldv + vc * 8) * 2u, pbv = s1.v + (unsigned)(vr * s1.ldv + vc * 8) * 2u;
    const unsigned sav = (unsigned)s0.ldv * 128u, sbv = (unsigned)s1.ldv * 128u;
#define ATT_LOAD(ti, S_) do { const bool f_ = (ti) < T0; const unsigned t_ = (unsigned)(f_ ? (ti) : (ti) - T0); \
        rk0[S_] = *(const u32x4*)(wsb + (size_t)((f_ ? pa0 : pb0) + t_ * (f_ ? sa0 : sb0))); \
        if (has2) rk1[S_] = *(const u32x4*)(wsb + (size_t)((f_ ? pa1 : pb1) + t_ * (f_ ? sa1 : sb1))); \
        rv[S_] = *(const u32x4*)(wsb + (size_t)((f_ ? pav : pbv) + t_ * (f_ ? sav : sbv))); } while (0)
#pragma unroll
    for (int s_ = 0; s_ < 4; ++s_) { if (s_ < T) ATT_LOAD(s_, s_); }
    const int qrow = qrow0 + (w >> 1);
    const int qc0 = ((32 * w) & 63) + fr;
    const int bstart = min(max(qrow - 4, 0), 8);
    int dcv[NQ][16]; unsigned vmask[NQ];
#pragma unroll
    for (int qi = 0; qi < NQ; ++qi) {
        vmask[qi] = 0u;
        if (NAL) {
            const int qcol = qc0 + 16 * qi, cs = min(max(qcol - 8, 0), 48);
#pragma unroll
            for (int i = 0; i < 16; ++i) {
                const int kcol = 16 * (i >> 2) + 4 * fq + (i & 3), rel = kcol - cs;
                dcv[qi][i] = min(max(kcol - qcol + 15, 0), 30);
                vmask[qi] |= (rel >= 0 && rel < 16) ? (1u << i) : 0u;
            }
        } else {
#pragma unroll
            for (int i = 0; i < 16; ++i) dcv[qi][i] = 0;
        }
    }
#define ATT_BAR() do { asm volatile("s_waitcnt lgkmcnt(0)" ::: "memory"); __builtin_amdgcn_s_barrier(); asm volatile("" ::: "memory"); } while (0)
    {
        *(LAS u32x4*)(lds + kr0 * KSTR + kc0 * 16) = rk0[0];
        if (has2) *(LAS u32x4*)(lds + kr1 * KSTR + kc1 * 16) = rk1[0];
        *(LAS u32x4*)(lds + 13312 + vr * VSTR + vc * 16) = rv[0];
        if (4 < T) ATT_LOAD(4, 0);
        ATT_BAR();
    }
    for (int tb = 0; tb < T; tb += 4) {
#pragma unroll
      for (int s_ = 0; s_ < 4; ++s_) {
        const int ti = tb + s_;
        if (ti >= T) break;
        LAS unsigned char* Kt = lds + (s_ & 1) * 24576;
        LAS unsigned char* Vt = Kt + 13312;
        if (ti + 1 < T) {
            LAS unsigned char* Kn = lds + ((s_ + 1) & 1) * 24576;
            *(LAS u32x4*)(Kn + kr0 * KSTR + kc0 * 16) = rk0[(s_ + 1) & 3];
            if (has2) *(LAS u32x4*)(Kn + kr1 * KSTR + kc1 * 16) = rk1[(s_ + 1) & 3];
            *(LAS u32x4*)(Kn + 13312 + vr * VSTR + vc * 16) = rv[(s_ + 1) & 3];
            if (ti + 5 < T) ATT_LOAD(ti + 5, (s_ + 1) & 3);
        }
        const bool local = NAL && (ti >= T0);
        const int krow = rb0 + (ti - T0);
        if (!(local && (krow < bstart || krow >= bstart + 8))) {
        f32x4 st[NQ][4];
#pragma unroll
        for (int kb = 0; kb < 4; ++kb) {
#pragma unroll
            for (int qi = 0; qi < NQ; ++qi) st[qi][kb] = (f32x4){0.f, 0.f, 0.f, 0.f};
#pragma unroll
            for (int ks = 0; ks < NKS; ++ks) {
                const bf16x8 kf = *(const LAS bf16x8*)(Kt + (16 * kb + fr) * KSTR + (32 * ks + 8 * fq) * 2);
#pragma unroll
                for (int qi = 0; qi < NQ; ++qi) st[qi][kb] = __builtin_amdgcn_mfma_f32_16x16x32_bf16(kf, qf[qi][ks], st[qi][kb], 0, 0, 0);
            }
        }
        bf16x8 pa[NQ][2];
#pragma unroll
        for (int qi = 0; qi < NQ; ++qi) {
            float mx = -INFINITY;
            if (local) {
                const LAS float* brow = biasL + (krow - qrow + 7) * 31;
#pragma unroll
                for (int kb = 0; kb < 4; ++kb)
#pragma unroll
                    for (int j = 0; j < 4; ++j) {
                        const float bb = brow[dcv[qi][kb * 4 + j]];
                        const float t = ((vmask[qi] >> (kb * 4 + j)) & 1u) ? st[qi][kb][j] * sc_log2 + bb : -1e30f;
                        st[qi][kb][j] = t; mx = fmaxf(mx, t);
                    }
            } else {
#pragma unroll
                for (int kb = 0; kb < 4; ++kb)
#pragma unroll
                    for (int j = 0; j < 4; ++j) { const float t = st[qi][kb][j] * sc_log2; st[qi][kb][j] = t; mx = fmaxf(mx, t); }
            }
            mx = fmaxf(mx, shfl_x(mx, 16, lane)); mx = fmaxf(mx, shfl_x(mx, 32, lane));
            const float mold = mrun[qi], mnew = fmaxf(mold, mx);
            mrun[qi] = mnew;
            float ps = 0.f;
#pragma unroll
            for (int kb = 0; kb < 4; ++kb)
#pragma unroll
                for (int j = 0; j < 4; ++j) { const float p = __builtin_amdgcn_exp2f(st[qi][kb][j] - mnew); st[qi][kb][j] = p; ps += p; }
            if (__builtin_amdgcn_ballot_w64(mnew > mold) != 0ull) {
                const float alpha = __builtin_amdgcn_exp2f(mold - mnew);
                lsum[qi] *= alpha;
#pragma unroll
                for (int c = 0; c < 4; ++c) ot[qi][c] = ot[qi][c] * alpha;
            }
            lsum[qi] += ps;
#pragma unroll
            for (int ks2 = 0; ks2 < 2; ++ks2) {
                u32x4 pw; pw.x = cvt_pk_bf16(st[qi][2 * ks2][0], st[qi][2 * ks2][1]); pw.y = cvt_pk_bf16(st[qi][2 * ks2][2], st[qi][2 * ks2][3]);
                pw.z = cvt_pk_bf16(st[qi][2 * ks2 + 1][0], st[qi][2 * ks2 + 1][1]); pw.w = cvt_pk_bf16(st[qi][2 * ks2 + 1][2], st[qi][2 * ks2 + 1][3]);
                pa[qi][ks2] = __builtin_bit_cast(bf16x8, pw);
            }
        }
#pragma unroll
        for (int ks2 = 0; ks2 < 2; ++ks2)
#pragma unroll
            for (int c = 0; c < 4; ++c) {
                LAS unsigned char* vb = Vt + (32 * ks2 + 4 * fq + (fr >> 2)) * VSTR + (16 * c + 4 * (fr & 3)) * 2;
                const s16x4 v0 = __builtin_amdgcn_ds_read_tr16_b64_v4i16((LAS s16x4*)vb);
                const s16x4 v1 = __builtin_amdgcn_ds_read_tr16_b64_v4i16((LAS s16x4*)(vb + 16 * VSTR));
                bf16x8 vf; vf[0] = v0[0]; vf[1] = v0[1]; vf[2] = v0[2]; vf[3] = v0[3]; vf[4] = v1[0]; vf[5] = v1[1]; vf[6] = v1[2]; vf[7] = v1[3];
#pragma unroll
                for (int qi = 0; qi < NQ; ++qi) ot[qi][c] = __builtin_amdgcn_mfma_f32_16x16x32_bf16(vf, pa[qi][ks2], ot[qi][c], 0, 0, 0);
            }
        }
        ATT_BAR();
      }
    }
#undef ATT_BAR
#undef ATT_LOAD
#pragma unroll
    for (int qi = 0; qi < NQ; ++qi) {
        float l = lsum[qi];
        l += shfl_x(l, 16, lane); l += shfl_x(l, 32, lane);
        const float inv = 1.f / l;
        bf16_t* orow = O + (size_t)(32 * w + 16 * qi + fr) * ldo + 4 * fq;
#pragma unroll
        for (int c = 0; c < 4; ++c) { u32x2 wv; wv.x = cvt_pk_bf16(ot[qi][c][0] * inv, ot[qi][c][1] * inv); wv.y = cvt_pk_bf16(ot[qi][c][2] * inv, ot[qi][c][3] * inv); *(u32x2*)(orow + 16 * c) = wv; }
    }
}

#define XB_TMO      128
#define XB_XCNT(j)  (256  + 64 * (j))
#define XB_XSUB(j)  (1280 + 64 * (j))
#define XB_XGEN(j)  (2304 + 64 * (j))
#define XB_TOP      3328
#define XB_TOPGEN   3392
#define XCD_BAR_WORDS 3456
#define XB_SPIN_CAP (1u << 22)
__device__ __forceinline__ unsigned xb_ld(unsigned* p)              { return __hip_atomic_load(p, __ATOMIC_RELAXED, __HIP_MEMORY_SCOPE_AGENT); }
__device__ __forceinline__ unsigned xb_add(unsigned* p, unsigned v) { return __hip_atomic_fetch_add(p, v, __ATOMIC_RELAXED, __HIP_MEMORY_SCOPE_AGENT); }
__device__ __forceinline__ unsigned xb_xcc_id() { return (unsigned)__builtin_amdgcn_s_getreg((3 << 11) | 20) & 0xFu; }
#define XB_SPIN(cond, bar) do { unsigned _sp = 0; while (cond) { __builtin_amdgcn_s_sleep(1); \
    if ((++_sp & 255u) == 0u) { if (xb_ld(&(bar)[XB_TMO])) break; if (_sp > XB_SPIN_CAP) { atomicAdd(&(bar)[XB_TMO], 1u); break; } } } } while (0)
struct XcdBarrier { unsigned* bar; unsigned x; volatile LAS unsigned* st; };
__device__ __forceinline__ void xcd_barrier_complete(unsigned* bar, unsigned x, unsigned& nloc, unsigned& nx) {
    const unsigned G = gridDim.x;
    unsigned sum, cnt, mine, sp = 0u;
    for (;;) {
        sum = 0u; cnt = 0u; mine = 0u;
#pragma unroll
        for (unsigned j = 0; j < 16; ++j) { const unsigned c = xb_ld(&bar[XB_XCNT(j)]); sum += c; cnt += (c > 0u) ? 1u : 0u; mine = (j == x) ? c : mine; }
        if (sum == G) break;
        __builtin_amdgcn_s_sleep(1);
        if ((++sp & 255u) == 0u) { if (xb_ld(&bar[XB_TMO])) break; if (sp > XB_SPIN_CAP) { atomicAdd(&bar[XB_TMO], 1u); break; } }
    }
    nloc = mine > 0u ? mine : 1u; nx = cnt > 0u ? cnt : 1u;
}
__device__ __forceinline__ void xcd_barrier(const XcdBarrier& b, const int wave_s) {
    asm volatile("s_waitcnt vmcnt(0)" ::: "memory");
    __syncthreads();
    if (wave_s == 0) { if (lane_id_v() == 0) {
        unsigned* bar = b.bar;
        __builtin_amdgcn_s_waitcnt(0);
        unsigned nloc = b.st[0], nx = b.st[1];
        if (nloc == 0u) { xcd_barrier_complete(bar, b.x, nloc, nx); b.st[0] = nloc; b.st[1] = nx; }
        const unsigned old = xb_add(&bar[XB_XSUB(b.x)], 1u);
        const unsigned gen = old / nloc;
        if (old + 1u == (gen + 1u) * nloc) {
            __builtin_amdgcn_fence(__ATOMIC_RELEASE, "agent");
            asm volatile("s_waitcnt vmcnt(0)" ::: "memory");
            const unsigned og = xb_add(&bar[XB_TOP], 1u);
            const unsigned tg = og / nx;
            if (og + 1u == (tg + 1u) * nx) xb_add(&bar[XB_TOPGEN], 1u);
            else XB_SPIN(xb_ld(&bar[XB_TOPGEN]) == tg, bar);
            __builtin_amdgcn_fence(__ATOMIC_ACQUIRE, "agent");
            xb_add(&bar[XB_XGEN(b.x)], 1u);
            asm volatile("s_waitcnt vmcnt(0)" ::: "memory");
        } else {
            XB_SPIN(xb_ld(&bar[XB_XGEN(b.x)]) == gen, bar);
            __builtin_amdgcn_fence(__ATOMIC_ACQUIRE, "agent");
            asm volatile("s_waitcnt vmcnt(0)" ::: "memory");
        }
    } }
    __syncthreads();
}

__device__ __forceinline__ const float* ldptr(const unsigned long long* tab, int i) {
    const unsigned long long v = tab[i];
    const unsigned lo = __builtin_amdgcn_readfirstlane((unsigned)v), hi = __builtin_amdgcn_readfirstlane((unsigned)(v >> 32));
    return (const float*)(((unsigned long long)hi << 32) | lo);
}
struct Params { const float* in[30]; float* out; unsigned char* ws; int ph_lo, ph_hi; };

__device__ __forceinline__ void transpose_item(const float* W, int K, int N, bf16_t* WT, int map, LAS float* scr, int item, int lane, const float* shp = nullptr, float* swp = nullptr) {
    const int nblk = (N + 63) >> 6, kb = item / nblk, nb = item - kb * nblk, k0 = 64 * kb, n0 = 64 * nb;
    const int lc = 4 * (lane & 15), lr = lane >> 4;
    const bool okc = n0 + lc < N;
    f32x4 v[16];
#pragma unroll
    for (int i = 0; i < 16; ++i) v[i] = okc ? *(const f32x4*)(W + (size_t)(k0 + 4 * i + lr) * N + n0 + lc) : (f32x4){0.f, 0.f, 0.f, 0.f};
#pragma unroll
    for (int i = 0; i < 16; ++i) { LAS float* d = scr + (4 * i + lr) * 65 + lc; d[0] = v[i][0]; d[1] = v[i][1]; d[2] = v[i][2]; d[3] = v[i][3]; }
    asm volatile("s_waitcnt lgkmcnt(0)" ::: "memory");
    if (shp) {
        float shv[9], pacc[9];
#pragma unroll
        for (int mb = 0; mb < 9; ++mb) { shv[mb] = shp[(size_t)mb * 9216 + k0 + lane]; pacc[mb] = 0.f; }
#pragma unroll 8
        for (int kk = 0; kk < 64; ++kk) {
            const float w = scr[kk * 65 + lane];
#pragma unroll
            for (int mb = 0; mb < 9; ++mb) pacc[mb] += __builtin_bit_cast(float, __builtin_amdgcn_readlane(__builtin_bit_cast(int, shv[mb]), kk)) * w;
        }
        const int ng = n0 + lane; int r = ng;
        if (map == 1) r = (ng >> 7) * 256 + (ng & 127); else if (map == 2) r = (ng >> 7) * 256 + 128 + (ng & 127); else if (map == 3) r = ng >= 3488 ? ng + 96 : ng;
        if (ng < N) {
#pragma unroll
            for (int mb = 0; mb < 9; ++mb) unsafeAtomicAdd(swp + (size_t)mb * 6656 + r, pacc[mb]);
        }
    }
    const int c = lane & 7;
#pragma unroll
    for (int j = 0; j < 8; ++j) { const int n = (lane >> 3) + 8 * j; const LAS float* sp = scr + (8 * c) * 65 + n;
        u32x4 o; o.x = cvt_pk_bf16(sp[0 * 65], sp[1 * 65]); o.y = cvt_pk_bf16(sp[2 * 65], sp[3 * 65]); o.z = cvt_pk_bf16(sp[4 * 65], sp[5 * 65]); o.w = cvt_pk_bf16(sp[6 * 65], sp[7 * 65]);
        const int ng = n0 + n; int r = ng;
        if (map == 1) r = (ng >> 7) * 256 + (ng & 127); else if (map == 2) r = (ng >> 7) * 256 + 128 + (ng & 127); else if (map == 3) r = ng >= 3488 ? ng + 96 : ng;
        if (ng < N) *(u32x4*)(WT + (size_t)r * K + k0 + 8 * c) = o; }
    asm volatile("s_waitcnt lgkmcnt(0)" ::: "memory");
}

__global__ void __launch_bounds__(512, 2) fwd_kernel(Params p) {
    extern __shared__ __attribute__((aligned(16))) unsigned char lds_raw[];
    LAS unsigned char* lds = (LAS unsigned char*)lds_raw;
    cg::grid_group grid = cg::this_grid();
    const int G = gridDim.x;
    unsigned char* ws = p.ws;
    float* MOD = (float*)(ws + WS_MOD);
    f32x2* ROPE = (f32x2*)(ws + WS_ROPE);
    bf16_t* WB = (bf16_t*)(ws + WS_W);
    bf16_t* H = (bf16_t*)(ws + WS_H);
    bf16_t* YC = (bf16_t*)(ws + WS_H + HO_YC);
    bf16_t* CQN = (bf16_t*)(ws + WS_H + HO_CQN);
    bf16_t* CKVN = (bf16_t*)(ws + WS_H + HO_CKVN);
    bf16_t* KR = (bf16_t*)(ws + WS_H + HO_KR);
    bf16_t* U = (bf16_t*)(ws + WS_U);
    bf16_t* ACT = U;
    bf16_t* KVX = (bf16_t*)(ws + WS_KVX);
    bf16_t* CK = (bf16_t*)(ws + WS_CK);
    bf16_t* CV = (bf16_t*)(ws + WS_CV);
    float* X = p.out;
    float* SS = (float*)(ws + WS_SS);
    float* SW = (float*)(ws + WS_SW);

    LAS unsigned* stw = (LAS unsigned*)(lds + 139264);
    if (threadIdx.x < 4) stw[threadIdx.x] = 0u;
    __syncthreads();
    unsigned* barw = (unsigned*)(ws + WS_BAR);
    int ph = p.ph_lo;
    const int wave_s = __builtin_amdgcn_readfirstlane(threadIdx.x >> 6);
    const unsigned long long* tab = (const unsigned long long*)(ws + WS_TAB);
    XcdBarrier xb; xb.bar = barw; xb.x = xb_xcc_id(); xb.st = (volatile LAS unsigned*)stw;
    if (threadIdx.x == 0) (void)xb_add(&barw[XB_XCNT(xb.x)], 1u);
    if (ph == 0) {
        {
        int tid = threadIdx.x; asm volatile("" : "+v"(tid));
        int bid = blockIdx.x; asm volatile("" : "+s"(bid));
        const int lane = tid & 63, wave = __builtin_amdgcn_readfirstlane(tid >> 6);
        if (bid == 1) { for (int i = tid; i < 6 * 1024; i += 512) ((float*)(ws + WS_NG))[i] = p.in[10][i]; }
        if (bid == 2) { for (int i = tid; i < 1024; i += 512) ((float*)(ws + WS_FG))[i] = p.in[29][i]; for (int i = tid; i < 64 * 64; i += 512) ((unsigned*)(ws + WS_CNT))[i] = 0u; }
        { f32x4* wz = (f32x4*)SW; for (int i = bid * 512 + tid; i < 2 * 27 * 6656 / 4; i += G * 512) wz[i] = (f32x4){0.f, 0.f, 0.f, 0.f}; }
        { f32x4* sz = (f32x4*)SS; for (int i = bid * 512 + tid; i < 7 * M / 4; i += G * 512) sz[i] = (f32x4){0.f, 0.f, 0.f, 0.f}; }
        if (bid == 0 && tid == 0) {
            unsigned long long* tw = (unsigned long long*)(ws + WS_TAB);
#pragma unroll
            for (int i = 0; i < 30; ++i) tw[i] = (unsigned long long)p.in[i];
        }
        {
            LAS float* sl = (LAS float*)lds;
            LAS f32x2* red = (LAS f32x2*)(lds + 36864);
            for (int i = tid; i < 9 * 1024; i += 512) { const int mb = i >> 10, k = i & 1023; const float c = mb == 0 ? p.in[7][k] : p.in[6][(mb - 1) * 1024 + k];
                sl[i] = c * sigmoidf_(c); }
            __syncthreads();
            for (int item = bid; item < 256; item += G) {
                const int l = item >> 7, cb = item & 127, lc = lane < 36 ? lane : 35, col0 = cb * 72 + 2 * lc;
                const float* W = p.in[8] + (size_t)l * 1024 * 9216 + col0;
                float a0[9], a1[9];
#pragma unroll
                for (int mb = 0; mb < 9; ++mb) { a0[mb] = 0.f; a1[mb] = 0.f; }
#pragma unroll 8
                for (int k = wave * 128; k < wave * 128 + 128; ++k) {
                    const f32x2 wv = *(const f32x2*)(W + (size_t)k * 9216);
#pragma unroll
                    for (int mb = 0; mb < 9; ++mb) { const float s = sl[mb * 1024 + k]; a0[mb] += s * wv.x; a1[mb] += s * wv.y; }
                }
#pragma unroll
                for (int mb = 0; mb < 9; ++mb) red[(wave * 9 + mb) * 64 + lane] = (f32x2){a0[mb], a1[mb]};
                __syncthreads();
                for (int idx = tid; idx < 9 * 64; idx += 512) {
                    const int mb = idx >> 6, ln = idx & 63; f32x2 s = (f32x2){0.f, 0.f};
#pragma unroll
                    for (int wv = 0; wv < 8; ++wv) s = s + red[(wv * 9 + mb) * 64 + ln];
                    const int col = cb * 72 + 2 * ln;
                    if (ln < 36) { const f32x2 bv = *(const f32x2*)(p.in[9] + (size_t)l * 9216 + col);
                        *(f32x2*)(MOD + (size_t)(l * 9 + mb) * 9216 + col) = s + bv; }
                }
                __syncthreads();
            }
            if (bid == G - 1) {
                const int pos = tid >> 3, i = tid & 7;
                const float inv = __builtin_amdgcn_exp2f(-(float)i * 1.6609640474436813f);
                const float ang = (float)pos * inv;
                double rr = (double)ang * 0.15915494309189535; rr -= __builtin_rint(rr);
                const float rf = (float)rr;
                ROPE[pos * 8 + i] = (f32x2){__builtin_amdgcn_cosf(rf), __builtin_amdgcn_sinf(rf)};
            }
            { const int n4 = (8 * 2 * 8 * 256 * 64) / 4;
              for (int i = bid * 512 + tid; i < 2 * n4; i += G * 512) {
                  const bool kk = i < n4; const int j = kk ? i : i - n4;
                  const f32x4 v = *((const f32x4*)(kk ? p.in[2] : p.in[3]) + j);
                  u32x2 o; o.x = cvt_pk_bf16(v[0], v[1]); o.y = cvt_pk_bf16(v[2], v[3]);
                  *((u32x2*)(kk ? CK : CV) + j) = o; } }
        }
        }
        ph = 1;
        xcd_barrier(xb, wave_s);
    }
    if (p.ph_hi < 0) grid.sync();
    int did = 0; (void)did;
    for (; ph < p.ph_hi; ++ph) {
#define PHASE_IDS() int tid = wave_s * 64 + lane_id_v(); asm volatile("" : "+v"(tid)); int bid = blockIdx.x; asm volatile("" : "+s"(bid)); \
        const int lane = tid & 63, wave = __builtin_amdgcn_readfirstlane(tid >> 6); const int gw = bid * 8 + wave, NGW = G * 8; (void)lane; (void)gw; (void)NGW;
        if (ph == 27) {
            if (G == 256) break;
            PHASE_IDS();
            const float* g = ldptr(tab, 29);
            const float* ss = SS + 6 * M;
            for (int r = gw; r < M; r += NGW) {
                f32x4* xr = (f32x4*)(X + (size_t)r * D) + lane;
                const float rstd = rsqrtf(ss[r] * (1.f / D) + EPS);
#pragma unroll
                for (int j = 0; j < 4; ++j) { const f32x4 gv = *((const f32x4*)g + lane + 64 * j); xr[64 * j] = xr[64 * j] * rstd * gv; }
            }
        } else {
            const int l = (ph - 1) / 13, k = (ph - 1) % 13;
            const float* modl = MOD + (size_t)l * 9 * 9216;
            float* SWl = SW + (size_t)l * 27 * 6656;
            if (k == 0) {
                PHASE_IDS();
                if (l == 0) {
                    const float* g = ldptr(tab, 10);
                    for (int r = gw; r < M; r += NGW) {
                        const float* src = r < MP ? ldptr(tab, 0) + (size_t)r * D : ldptr(tab, 1) + (size_t)(r - MP) * D;
                        const f32x4* xr = (const f32x4*)src + lane;
                        const float* mv = modl + (size_t)mod_index(r) * 9216 + 1024;
                        f32x4 v[4]; float s = 0.f;
#pragma unroll
                        for (int j = 0; j < 4; ++j) { v[j] = xr[64 * j]; s += (v[j].x * v[j].x + v[j].y * v[j].y) + (v[j].z * v[j].z + v[j].w * v[j].w); }
                        s = wave_sum(s, lane);
                        if (lane == 0) SS[r] = s;
                        f32x4* xo = (f32x4*)(X + (size_t)r * D) + lane;
                        u32x2* ho = (u32x2*)(H + (size_t)r * D) + lane;
#pragma unroll
                        for (int j = 0; j < 4; ++j) {
                            xo[64 * j] = v[j];
                            const f32x4 gv = *((const f32x4*)g + lane + 64 * j), sc = *((const f32x4*)mv + lane + 64 * j);
                            const f32x4 h = v[j] * gv * (sc + 1.f);
                            u32x2 o; o.x = cvt_pk_bf16(h[0], h[1]); o.y = cvt_pk_bf16(h[2], h[3]); ho[64 * j] = o;
                        }
                    }
                }
                {
                    LAS float* scr = (LAS float*)(lds + wave * 16640);
                    constexpr int I_F = 16 * 44, I_IN = 16 * 103, I_UQ = 4 * 12, I_UKV = 2 * 16, I_B = 8 * 16, I_O = 16 * 16;
                    constexpr int NIT = 6 * I_F + I_IN + I_UQ + I_UKV + 3 * I_B + I_O;
                    for (int it = gw; it < NIT; it += NGW) {
                        int r = it;
                        if (r < I_F) { transpose_item(ldptr(tab, 11) + (size_t)l * D * FF, D, FF, WB + WO_GU1, 1, scr, r, lane, modl + 0 * 3072, SWl + (size_t)0 * 9 * 6656); continue; } r -= I_F;
                        if (r < I_F) { transpose_item(ldptr(tab, 12) + (size_t)l * D * FF, D, FF, WB + WO_GU1, 2, scr, r, lane, modl + 0 * 3072, SWl + (size_t)0 * 9 * 6656); continue; } r -= I_F;
                        if (r < I_F) { transpose_item(ldptr(tab, 13) + (size_t)l * D * FF, FF, D, WB + WO_D1, 0, scr, r, lane); continue; } r -= I_F;
                        if (r < I_F) { transpose_item(ldptr(tab, 14) + (size_t)l * D * FF, D, FF, WB + WO_GU2, 1, scr, r, lane, modl + 2 * 3072, SWl + (size_t)2 * 9 * 6656); continue; } r -= I_F;
                        if (r < I_F) { transpose_item(ldptr(tab, 15) + (size_t)l * D * FF, D, FF, WB + WO_GU2, 2, scr, r, lane, modl + 2 * 3072, SWl + (size_t)2 * 9 * 6656); continue; } r -= I_F;
                        if (r < I_F) { transpose_item(ldptr(tab, 16) + (size_t)l * D * FF, FF, D, WB + WO_D2, 0, scr, r, lane); continue; } r -= I_F;
                        if (r < I_IN) { transpose_item(ldptr(tab, 17) + (size_t)l * D * 6560, D, 6560, WB + WO_IN, 3, scr, r, lane, modl + 1 * 3072, SWl + (size_t)1 * 9 * 6656); continue; } r -= I_IN;
                        if (r < I_UQ) { transpose_item(ldptr(tab, 22) + (size_t)l * 256 * 768, 256, 768, WB + WO_UQ, 0, scr, r, lane); continue; } r -= I_UQ;
                        if (r < I_UKV) { transpose_item(ldptr(tab, 24) + (size_t)l * 128 * 1024, 128, 1024, WB + WO_UKV, 0, scr, r, lane); continue; } r -= I_UKV;
                        if (r < I_B) { transpose_item(ldptr(tab, 25) + (size_t)l * 512 * D, 512, D, WB + WO_C, 0, scr, r, lane); continue; } r -= I_B;
                        if (r < I_B) { transpose_item(ldptr(tab, 26) + (size_t)l * 512 * D, 512, D, WB + WO_N, 0, scr, r, lane); continue; } r -= I_B;
                        if (r < I_B) { transpose_item(ldptr(tab, 27) + (size_t)l * 512 * D, 512, D, WB + WO_M, 0, scr, r, lane); continue; } r -= I_B;
                        transpose_item(ldptr(tab, 28) + (size_t)l * D * D, D, D, WB + WO_O, 0, scr, r, lane);
                    }
                }
            } else if (k == 1) {
            } else if (k == 2 || k == 11) {
                PHASE_IDS();
                pg8::Gemm g{H, WB + (k == 2 ? WO_GU1 : WO_GU2), D, D, D};
                pg8::StaticOrder S; S.init(M, 5632, G, bid);
                EpiSwiglu E{ACT, SS + (size_t)(3 * l + (k == 2 ? 0 : 2)) * M, SWl + (size_t)(k == 2 ? 0 : 2) * 9 * 6656};
                pg8::gemm_phase<EpiSwiglu>(lds, tid, g, S, E);
            } else if (k == 3 || k == 12 || k == 10) {
                PHASE_IDS();
                pg8::Gemm g;
                if (k == 10) g = pg8::Gemm{U + UC_Z, WB + WO_O, UN, D, D};
                else g = pg8::Gemm{ACT, WB + (k == 3 ? WO_D1 : WO_D2), FF, FF, FF};
                pg8::StaticOrder S; S.init(M, D, G, bid);
                const int w = k == 3 ? 1 : (k == 10 ? 2 : 3);
                const int ln = w == 3 ? l + 1 : l, wn = w == 3 ? 0 : w;
                const bool hasn = ln < NL;
                if (!hasn && G == 256) {
                    EpiResidT<true> E{X, ws, 0.5f, l * 9 * 9216 + 8 * 1024, 3 * l + w, -2, 0};
                    pg8::gemm_phase<EpiResidT<true>>(lds, tid, g, S, E);
                } else {
                    EpiResidT<false> E{X, ws, k == 10 ? 1.0f : 0.5f, l * 9 * 9216 + (k == 3 ? 2 : (k == 10 ? 5 : 8)) * 1024, 3 * l + w,
                               hasn ? (ln * 3 + wn) * D : -1, (hasn ? ln : 0) * 9 * 9216 + (3 * wn + 1) * 1024};
                    pg8::gemm_phase<EpiResidT<false>>(lds, tid, g, S, E);
                }
            } else if (k == 4) {
                PHASE_IDS();
                pg8::Gemm g{H, WB + WO_IN, D, D, D};
                pg8::StaticOrder S; S.init(M, UN, G, bid);
                EpiIn E{U, p.out, l, SS + (size_t)(3 * l + 1) * M, SWl + (size_t)1 * 9 * 6656};
                pg8::gemm_phase<EpiIn>(lds, tid, g, S, E);
            } else if (k == 5) {
                PHASE_IDS();
                const float* cw = ldptr(tab, 18) + (size_t)l * 3 * 512; const float* cbias = ldptr(tab, 19) + (size_t)l * 512;
                const float* qn = ldptr(tab, 21) + (size_t)l * 256; const float* kvn = ldptr(tab, 23) + (size_t)l * 128;
#define PREP_LOAD(R_, X) \
                    const int r##X = (R_); const bf16_t* ur##X = U + (size_t)r##X * UN; \
                    const bool smp##X = r##X >= MP; const int s##X = smp##X ? ((r##X - MP) & 1023) : (r##X & 255); \
                    const bool hasp##X = s##X != 0, hasn##X = smp##X ? (s##X != 1023) : (s##X != 255); \
                    const int c##X = 8 * lane; \
                    const u32x4 bg##X = *(const u32x4*)(ur##X + UC_BG + c##X), cg0##X = *(const u32x4*)(ur##X + UC_CG + c##X), xc0##X = *(const u32x4*)(ur##X + UC_XC + c##X); \
                    u32x4 cgp##X = (u32x4){0u, 0u, 0u, 0u}, xcp##X = cgp##X, cgn##X = cgp##X, xcn##X = cgp##X; \
                    if (hasp##X) { cgp##X = *(const u32x4*)(ur##X - UN + UC_CG + c##X); xcp##X = *(const u32x4*)(ur##X - UN + UC_XC + c##X); } \
                    if (hasn##X) { cgn##X = *(const u32x4*)(ur##X + UN + UC_CG + c##X); xcn##X = *(const u32x4*)(ur##X + UN + UC_XC + c##X); } \
                    const u32x2 vq##X = *(const u32x2*)(ur##X + UC_CQ + 4 * lane); \
                    const unsigned vk##X = *(const unsigned*)(ur##X + UC_CKV + 2 * lane); \
                    const bf16_t vr##X = ur##X[UC_KR + (lane & 31)];
#define PREP_DONE(X) { \
                    u32x4 ycw; \
                    {   float o[8]; \
                        _Pragma("unroll") for (int q = 0; q < 4; ++q) { \
                            _Pragma("unroll") for (int hh = 0; hh < 2; ++hh) { \
                                const int ch = c##X + 2 * q + hh; \
                                const float pb = hh ? bf_hi(bg##X[q]) : bf_lo(bg##X[q]); \
                                const float pc = (hh ? bf_hi(cg0##X[q]) : bf_lo(cg0##X[q])) * (hh ? bf_hi(xc0##X[q]) : bf_lo(xc0##X[q])); \
                                const float pp = (hh ? bf_hi(cgp##X[q]) : bf_lo(cgp##X[q])) * (hh ? bf_hi(xcp##X[q]) : bf_lo(xcp##X[q])); \
                                const float pn = (hh ? bf_hi(cgn##X[q]) : bf_lo(cgn##X[q])) * (hh ? bf_hi(xcn##X[q]) : bf_lo(xcn##X[q])); \
                                o[2 * q + hh] = pb * (cbias[ch] + cw[ch] * pp + cw[512 + ch] * pc + cw[1024 + ch] * pn); \
                            } \
                        } \
                        ycw.x = cvt_pk_bf16(o[0], o[1]); ycw.y = cvt_pk_bf16(o[2], o[3]); ycw.z = cvt_pk_bf16(o[4], o[5]); ycw.w = cvt_pk_bf16(o[6], o[7]); \
                    } \
                    {   const float a0 = bf_lo(vq##X.x), a1 = bf_hi(vq##X.x), a2 = bf_lo(vq##X.y), a3 = bf_hi(vq##X.y); \
                        const float rstd = 1.f / sqrtf(wave_sum(a0 * a0 + a1 * a1 + a2 * a2 + a3 * a3, lane) * (1.f / 256.f) + EPS); \
                        const f32x4 gq = *(const f32x4*)(qn + 4 * lane); \
                        u32x2 o; o.x = cvt_pk_bf16(a0 * rstd * gq[0], a1 * rstd * gq[1]); o.y = cvt_pk_bf16(a2 * rstd * gq[2], a3 * rstd * gq[3]); \
                        *(u32x2*)(CQN + (size_t)r##X * 256 + 4 * lane) = o; \
                    } \
                    {   const float a0 = bf_lo(vk##X), a1 = bf_hi(vk##X); \
                        const float rstd = 1.f / sqrtf(wave_sum(a0 * a0 + a1 * a1, lane) * (1.f / 128.f) + EPS); \
                        const f32x2 gk = *(const f32x2*)(kvn + 2 * lane); \
                        const float o0 = a0 * rstd * gk.x, o1 = a1 * rstd * gk.y; \
                        *(unsigned*)(CKVN + (size_t)r##X * 128 + 2 * lane) = cvt_pk_bf16(o0, o1); \
                        if (!smp##X) *(f32x2*)(p.out + OUT_CKV + ((size_t)((r##X >> 8) * 2 + l) * 256 + (r##X & 255)) * 128 + 2 * lane) = (f32x2){o0, o1}; \
                    } \
                    {   const int e = lane & 31; \
                        float v = bf1(vr##X); \
                        const float pr = shfl_x(v, 8, lane); \
                        if (smp##X) { \
                            const int pos = (e >= 16) ? (s##X & 63) : (s##X >> 6); \
                            const f32x2 cs = ROPE[pos * 8 + (e & 7)]; \
                            v = (e & 8) ? (pr * cs.y + v * cs.x) : (v * cs.x - pr * cs.y); \
                        } \
                        if (lane < 32) KR[(size_t)r##X * 32 + e] = f2bf(v); \
                    } \
                    *(u32x4*)((bf16_t*)ur##X + UC_YC + 8 * lane) = ycw;     \
                }
                for (int r = gw; r < M; r += 2 * NGW) {
                    const int r2 = r + NGW; const bool two = r2 < M;
                    PREP_LOAD(r, A)
                    PREP_LOAD(two ? r2 : r, B)
                    PREP_DONE(A)
                    if (two) PREP_DONE(B)
                }
#undef PREP_LOAD
#undef PREP_DONE
                for (int r = M + gw; r < M + 2048; r += NGW) {
                    const int idx = r - M, b = idx >> 8, pp = idx & 255;
                    const f32x2 v = *(const f32x2*)(ldptr(tab, 4) + ((size_t)(b * 2 + l) * 256 + pp) * 128 + 2 * lane);
                    *(unsigned*)(CKVN + (size_t)r * 128 + 2 * lane) = cvt_pk_bf16(v.x, v.y);
                    if (lane < 32) KR[(size_t)r * 32 + lane] = f2bf(ldptr(tab, 5)[((size_t)(b * 2 + l) * 256 + pp) * 32 + lane]);
                }
            } else if (k == 6) {
                PHASE_IDS();
                int kq = 256; asm volatile("" : "+s"(kq));
                pg8::Gemm g{CQN, WB + WO_UQ, kq, kq, kq};
                pg8::StaticOrder S; S.init(M, 768, G, bid);
                EpiQ E{U, ROPE};
                pg8::gemm_phase<EpiQ>(lds, tid, g, S, E);
            } else if (k == 7) {
                PHASE_IDS();
                pg8::Gemm g{CKVN, WB + WO_UKV, 128, 128, 128};
                pg8::StaticOrder S; S.init(M + 2048, 1024, G, (bid + 192) % G);
                EpiPlain E{KVX, 1024};
                pg8::gemm_phase<EpiPlain>(lds, tid, g, S, E);
            } else if (k == 8) {
                PHASE_IDS();
                const float sc_na = 0.125f * LOG2E, sc_mla = 0.10206207261596575f * LOG2E;
                const int ona_col = UC_ONA;
                for (int u = bid; u < 1024; u += G) {
                    const int type = u >> 8, v = u & 255;
                    if (type == 0) {
                        const int bh = (v & 7) + 8 * (v >> 5), b = bh >> 3, h = bh & 7, qb = (v >> 3) & 3;
                        const size_t r0 = MP + (size_t)b * 1024, rq = r0 + qb * 256, rc = M + (size_t)b * 256;
                        AttnSeg s0{(unsigned)(WS_KVX + (rc * 1024 + h * 128) * 2), (unsigned)(WS_H + HO_KR + rc * 32 * 2), (unsigned)(WS_KVX + (rc * 1024 + h * 128 + 64) * 2), 1024, 32, 1024, 256};
                        AttnSeg s1{(unsigned)(WS_KVX + (r0 * 1024 + h * 128) * 2), (unsigned)(WS_H + HO_KR + r0 * 32 * 2), (unsigned)(WS_KVX + (r0 * 1024 + h * 128 + 64) * 2), 1024, 32, 1024, 1024};
                        attn_unit<96, false>(lds, tid, ws, U + rq * UN + UC_QM + h * 96, UN, U + rq * UN + UC_OM + h * 64, UN, s0, s1, sc_mla, 0, 0, nullptr);
                    } else if (type == 1) {
                        const int bh = (v & 7) + 8 * (v >> 5), b = bh >> 3, h = bh & 7, qb = (v >> 3) & 3;
                        const size_t r0 = MP + (size_t)b * 1024, rq = r0 + qb * 256;
                        const int qrow0 = 4 * qb, rb0 = min(max(qrow0 - 4, 0), 8), rb1 = min(max(qrow0 + 3 - 4, 0), 8) + 8;
                        const size_t co = ((size_t)((b * 2 + l) * 8 + h) * 256) * 64;
                        AttnSeg s0{(unsigned)(WS_CK + co * 2), (unsigned)(WS_CK + co * 2), (unsigned)(WS_CV + co * 2), 64, 64, 64, 256};
                        const size_t rl = r0 + (size_t)rb0 * 64;
                        AttnSeg s1{(unsigned)(WS_U + (rl * UN + UC_KNA + h * 64) * 2), (unsigned)(WS_U + (rl * UN + UC_KNA + h * 64) * 2), (unsigned)(WS_U + (rl * UN + UC_VNA + h * 64) * 2), UN, UN, UN, (rb1 - rb0) * 64};
                        attn_unit<64, true>(lds, tid, ws, U + rq * UN + UC_QNA + h * 64, UN, U + rq * UN + ona_col + h * 64, UN, s0, s1, sc_na, qrow0, rb0,
                                            ldptr(tab, 20) + (size_t)(l * 8 + h) * 465);
                    } else if (type == 2) {
                        const int b = v >> 3, h = v & 7;
                        const size_t r0 = (size_t)b * 256;
                        AttnSeg s0{(unsigned)(WS_U + (r0 * UN + UC_KNA + h * 64) * 2), (unsigned)(WS_U + (r0 * UN + UC_KNA + h * 64) * 2), (unsigned)(WS_U + (r0 * UN + UC_VNA + h * 64) * 2), UN, UN, UN, 256};
                        AttnSeg s1 = s0; s1.nkeys = 0;
                        attn_unit<64, false>(lds, tid, ws, U + r0 * UN + UC_QNA + h * 64, UN, U + r0 * UN + ona_col + h * 64, UN, s0, s1, sc_na, 0, 0, nullptr);
                    } else {
                        const int b = v >> 3, h = v & 7;
                        const size_t r0 = (size_t)b * 256;
                        AttnSeg s0{(unsigned)(WS_KVX + (r0 * 1024 + h * 128) * 2), (unsigned)(WS_H + HO_KR + r0 * 32 * 2), (unsigned)(WS_KVX + (r0 * 1024 + h * 128 + 64) * 2), 1024, 32, 1024, 256};
                        AttnSeg s1 = s0; s1.nkeys = 0;
                        attn_unit<96, false>(lds, tid, ws, U + r0 * UN + UC_QM + h * 96, UN, U + r0 * UN + UC_OM + h * 64, UN, s0, s1, sc_mla, 0, 0, nullptr);
                    }
                }
            } else if (k == 9) {
                PHASE_IDS();
                pg8::Gemm g{U, WB + WO_C, UN, 512, 512};
                pg8::StaticOrder S; S.init(M, D, G, bid, 3);
                EpiZ3 E{U};
                pg8::gemm_phase<EpiZ3, true>(lds, tid, g, S, E);
            }
        }
        if (ph + 1 < p.ph_hi && !(ph != 27 && ((ph - 1) % 13) == 6) && !(ph != 27 && ((ph - 1) % 13) == 1) && !(ph == 26 && G == 256)) xcd_barrier(xb, wave_s);
        if (PROBE_MASK != 0) { if (ph != 27 && ((PROBE_MASK >> ((ph - 1) % 13)) & 1) && !did) { did = 1; if (((ph - 1) % 13) == 6) xcd_barrier(xb, wave_s); --ph; } else did = 0; }
        for (int sr = 0; sr < PROBE_SYNC; ++sr) xcd_barrier(xb, wave_s);
    }
}

extern "C" void kernel_launch(void* const* d_in, const int* in_sizes, int n_in, void* d_out, int out_size, void* d_ws, size_t ws_size, hipStream_t stream) {
    static int grid = 0;
    if (grid == 0) {
        if (n_in != 30 || ws_size < WS_END) { fprintf(stderr, "kernel_launch: unexpected n_in %d / ws_size %zu\n", n_in, ws_size); grid = -1; return; }
        int dev = 0, cus = 0, per_cu = 0;
        hipGetDevice(&dev);
        hipDeviceGetAttribute(&cus, hipDeviceAttributeMultiprocessorCount, dev);
        hipFuncSetAttribute((const void*)fwd_kernel, hipFuncAttributeMaxDynamicSharedMemorySize, LDS_BYTES);
        hipOccupancyMaxActiveBlocksPerMultiprocessor(&per_cu, (const void*)fwd_kernel, 512, LDS_BYTES);
        if (per_cu < 1) { fprintf(stderr, "kernel_launch: occupancy query says %d blocks/CU\n", per_cu); per_cu = 1; }
        if (per_cu > 1) per_cu = 1;
        grid = cus * per_cu;
        (void)hipGetLastError();
    }
    if (grid < 0) return;
    if (hipMemsetAsync((char*)d_ws + WS_BAR, 0, XCD_BAR_WORDS * 4, stream) != hipSuccess) { fprintf(stderr, "memset(bar) failed\n"); return; }
    Params p{};
    for (int i = 0; i < 30; ++i) p.in[i] = (const float*)d_in[i];
    p.out = (float*)d_out; p.ws = (unsigned char*)d_ws; p.ph_lo = 0; p.ph_hi = 28;
    void* args[] = {&p};
    hipError_t e = hipLaunchCooperativeKernel((const void*)fwd_kernel, dim3(grid), dim3(512), args, LDS_BYTES, stream);
    if (e != hipSuccess) fprintf(stderr, "cooperative launch failed: %s (grid %d)\n", hipGetErrorString(e), grid);
}
```

```cpp
#include <hip/hip_runtime.h>
#include <hip/hip_cooperative_groups.h>
#include <cstdio>
#include <cstdint>
namespace cg = cooperative_groups;

#define LAS __attribute__((address_space(3)))
typedef unsigned short bf16_t;
typedef short bf16x8 __attribute__((ext_vector_type(8)));
typedef short s16x4 __attribute__((ext_vector_type(4)));
typedef float f32x4 __attribute__((ext_vector_type(4)));
typedef float f32x2 __attribute__((ext_vector_type(2)));
typedef unsigned u32x4 __attribute__((ext_vector_type(4)));
typedef unsigned u32x2 __attribute__((ext_vector_type(2)));

constexpr int D = 1024, FF = 2816, M = 16384, MP = 8192, NL = 2;
constexpr int UN = 6656;
constexpr int UC_BG = 0, UC_CG = 512, UC_XC = 1024, UC_QNA = 1536, UC_KNA = 2048, UC_VNA = 2560, UC_CQ = 3072, UC_CKV = 3328, UC_KR = 3456, UC_G = 3584;
constexpr int UC_QM = 0;
constexpr int UC_ONA = UC_QNA;
constexpr int UC_OM = UC_XC;
constexpr int UC_YC = UC_CQ;
constexpr int UC_Z = UC_KNA;
constexpr float EPS = 1e-6f;
constexpr float LOG2E = 1.4426950408889634f;

constexpr size_t MiB = 1u << 20;
constexpr size_t WS_MOD = 0;
constexpr size_t WS_ROPE = 768 * 1024;
constexpr size_t WS_TAB = 800 * 1024;
constexpr size_t WS_NG = 808 * 1024;
constexpr size_t WS_BAR = 832 * 1024;
constexpr size_t WS_W = 1 * MiB;
constexpr size_t WS_H = 53 * MiB;
constexpr size_t WS_U = 85 * MiB;
constexpr size_t WS_KVX = 293 * MiB;
constexpr size_t WS_CK = 329 * MiB;
constexpr size_t WS_CV = 333 * MiB;
constexpr size_t WS_SS = 337 * MiB;
constexpr size_t WS_CNT = 337 * MiB + 512 * 1024;
constexpr size_t WS_FG = 776 * 1024;
constexpr size_t WS_SW = 338 * MiB;
constexpr size_t WS_END = 340 * MiB;
constexpr size_t WO_GU1 = 0, WO_D1 = WO_GU1 + 5632 * 1024, WO_IN = WO_D1 + 1024 * 2816, WO_UQ = WO_IN + (size_t)UN * 1024, WO_UKV = WO_UQ + 768 * 256,
                 WO_C = WO_UKV + 1024 * 128, WO_N = WO_C + 1024 * 512, WO_M = WO_N + 1024 * 512, WO_O = WO_M + 1024 * 512, WO_GU2 = WO_O + 1024 * 1024,
                 WO_D2 = WO_GU2 + 5632 * 1024, WO_END = WO_D2 + 1024 * 2816;
static_assert(WO_END * 2 <= 52 * MiB, "weights fit");
constexpr size_t HO_YC = 0, HO_CQN = 16 * MiB, HO_CKVN = 24 * MiB, HO_KR = 24 * MiB + 4718592;
static_assert(HO_KR + 18432 * 32 * 2 <= 32 * MiB, "H region");
constexpr size_t OUT_YS = 8388608, OUT_NK = 16777216, OUT_NV = 25165824, OUT_CKV = 33554432, OUT_KR = 35651584;

constexpr int LDS_BYTES = 147456;
#ifndef PROBE_MASK
#define PROBE_MASK 0
#endif
#ifndef PROBE_SYNC
#define PROBE_SYNC 0
#endif

__device__ __forceinline__ unsigned cvt_pk_bf16(float lo, float hi) { unsigned r; asm volatile("v_cvt_pk_bf16_f32 %0, %1, %2" : "=v"(r) : "v"(lo), "v"(hi)); return r; }
__device__ __forceinline__ float bf_lo(unsigned x) { return __builtin_bit_cast(float, x << 16); }
__device__ __forceinline__ float bf_hi(unsigned x) { return __builtin_bit_cast(float, x & 0xffff0000u); }
__device__ __forceinline__ float bf1(bf16_t x) { return __builtin_bit_cast(float, (unsigned)x << 16); }
__device__ __forceinline__ bf16_t f2bf(float f) { return (bf16_t)(cvt_pk_bf16(f, 0.f) & 0xffffu); }
__device__ __forceinline__ float shfl_x(float v, int mask, int lane) { return __builtin_bit_cast(float, __builtin_amdgcn_ds_bpermute((lane ^ mask) << 2, __builtin_bit_cast(int, v))); }
__device__ __forceinline__ float wave_sum(float v, int lane) {
#pragma unroll
    for (int o = 1; o < 64; o <<= 1) v += shfl_x(v, o, lane);
    return v;
}
__device__ __forceinline__ float sigmoidf_(float x) { return __builtin_amdgcn_rcpf(1.f + __builtin_amdgcn_exp2f(-x * LOG2E)); }
__device__ __forceinline__ int lane_id_v() { int x; asm volatile("v_mbcnt_lo_u32_b32 %0, -1, 0\n\tv_mbcnt_hi_u32_b32 %0, -1, %0" : "=&v"(x)); return x; }
__device__ __forceinline__ int mod_index(int row) { return row < MP ? 0 : 1 + ((row - MP) >> 10); }

namespace pg8 {
constexpr int BM = 256, BK = 64, HALF = 128, HTB = HALF * BK * 2, STAGE_BYTES = 8 * HTB, NXCD = 8, WGM = 8;
__host__ __device__ __forceinline__ int lds_byte(int r, int c) { const int st = (r >> 4) * 2 + (c >> 5), rr = r & 15, cc = c & 31, ob = rr * 64 + cc * 2; return st * 1024 + (ob ^ (((ob >> 9) & 1) << 5)); }
__host__ __device__ __forceinline__ void stage_rc(int b, int& R, int& C) { const int st = b / 1024, sb = b % 1024, swz = sb ^ (((sb >> 9) & 1) << 5); R = (st >> 1) * 16 + swz / 64; C = (st & 1) * 32 + (swz % 64) / 2; }
__host__ __device__ __forceinline__ int perm32(int rho) { const int n = rho >> 4, i = rho & 15; return 8 * (i >> 2) + 4 * n + (i & 3); }
struct Unit { int pm, pn, seg; };
struct Gemm { const bf16_t* A; const bf16_t* Bt; int lda, ldb, K; };
struct StaticOrder {
    int nM, nN, nwg, G, c, segs;
    __device__ void init(int M_, int N_, int G_, int c_, int segs_ = 1) { nM = M_ / BM; nN = N_ / BM; nwg = nM * nN; G = G_; c = c_; segs = segs_; }
    __device__ bool next(int i, Unit& u) const {
        const int ir = i / segs; u.seg = i - ir * segs;
        const long L = (long)ir * G + c; if (L >= nwg) return false;
        int wgid = (int)L; { const int q = nwg / NXCD, r = nwg % NXCD, xcd = wgid % NXCD, off = wgid / NXCD; wgid = (xcd < r ? xcd * (q + 1) : r * (q + 1) + (xcd - r) * q) + off; }
        const int nig = WGM * nN, gid = wgid / nig, fm = gid * WGM, gsz = (nM - fm) < WGM ? (nM - fm) : WGM;
        u.pm = fm + ((wgid % nig) % gsz); u.pn = (wgid % nig) / gsz; return true;
    }
};
template <class Epi, bool SEG3 = false>
__device__ __forceinline__ void gemm_phase(LAS unsigned char* lds, const int tid, const Gemm g, const StaticOrder& S, const Epi& E) {
    const int wid = __builtin_amdgcn_readfirstlane(tid >> 6), lane = tid & 63, wr = wid >> 2, wc = wid & 3, fr = lane & 15, fq = lane >> 4;
    const int K = g.K, nt = K / BK;
    unsigned voffA, voffB;
    { int R, C; stage_rc(tid * 16, R, C); const int Rb = (R & ~31) + perm32(R & 31);
      voffA = (unsigned)(R * g.lda + C) * 2u; voffB = (unsigned)(Rb * g.ldb + C) * 2u; }
    const unsigned q64voffA = 64u * (unsigned)g.lda * 2u, q64voffB = 64u * (unsigned)g.ldb * 2u;
    const unsigned kstep = (unsigned)(BK * 2);
    const unsigned hstepA = (unsigned)HALF * g.lda * 2u, hstepB = (unsigned)HALF * g.ldb * 2u;
    const unsigned tstepA = 2u * hstepA, tstepB = 2u * hstepB;
    const unsigned ldsw = (unsigned)wid * 1024u;
    const int aoff = lds_byte(wr * 64 + fr, fq * 8), boff = lds_byte(wc * 32 + fr, fq * 8);
#define PG8_SA(b, h) (((b) * 2 + (h)) * HTB)
#define PG8_SB(b, h) ((4 + (b) * 2 + (h)) * HTB)
#define PG8_STAGE(bufoff, gbase, voff) do { \
        __builtin_amdgcn_global_load_lds((const unsigned*)((const char*)(gbase) + (voff)), (LAS unsigned*)(lds + (bufoff) + ldsw), 16, 0, 0); \
        __builtin_amdgcn_global_load_lds((const unsigned*)((const char*)(gbase) + q64##voff + (voff)), (LAS unsigned*)(lds + (bufoff) + ldsw + 8192), 16, 0, 0); } while (0)
#define PG8_LDA(dst, b, h) do { _Pragma("unroll") for (int m = 0; m < 4; ++m) _Pragma("unroll") for (int k = 0; k < 2; ++k) dst[m][k] = *(const LAS bf16x8*)(lds + PG8_SA(b, h) + aoff + m * 2048 + k * 1024); } while (0)
#define PG8_LDB(dst, b, h) do { _Pragma("unroll") for (int n = 0; n < 2; ++n) _Pragma("unroll") for (int k = 0; k < 2; ++k) dst[n][k] = *(const LAS bf16x8*)(lds + PG8_SB(b, h) + boff + n * 2048 + k * 1024); } while (0)
#define PG8_MMA(ai, bj, At, Bt) do { __builtin_amdgcn_s_setprio(1); _Pragma("unroll") for (int m = 0; m < 4; ++m) _Pragma("unroll") for (int n = 0; n < 2; ++n) _Pragma("unroll") for (int k = 0; k < 2; ++k) \
        acc[ai][bj][m][n] = __builtin_amdgcn_mfma_f32_16x16x32_bf16(Bt[n][k], At[m][k], acc[ai][bj][m][n], 0, 0, 0); __builtin_amdgcn_s_setprio(0); } while (0)
#define PG8_WAIT_V(n) asm volatile("s_waitcnt vmcnt(" #n ")" ::: "memory")
#define PG8_WAIT_L(n) asm volatile("s_waitcnt lgkmcnt(" #n ")" ::: "memory")
#define PG8_BAR __builtin_amdgcn_s_barrier()
#define PG8_SCHED __builtin_amdgcn_sched_barrier(0)
    Unit cur, nxt; int ui = 0;
    if (!S.next(0, cur)) return;
    f32x4 acc[2][2][4][2];
#pragma unroll
    for (int a = 0; a < 2; ++a)
#pragma unroll
        for (int b = 0; b < 2; ++b)
#pragma unroll
            for (int m = 0; m < 4; ++m)
#pragma unroll
                for (int n = 0; n < 2; ++n) acc[a][b][m][n] = (f32x4){0.f, 0.f, 0.f, 0.f};
    bf16x8 At[4][2], B0[2][2], B1[2][2];
    if constexpr (Epi::PF) E.prefetch(lds, cur, 0, wid, lane);
    unsigned sgA = 0u, sgB = 0u; if constexpr (SEG3) { sgA = Epi::segA(cur.seg); sgB = Epi::segB(cur.seg); }
    const char* cA = (const char*)g.A + (size_t)cur.pm * tstepA + sgA; const char* cB = (const char*)g.Bt + (size_t)cur.pn * tstepB + sgB;
    PG8_STAGE(PG8_SB(0, 0), cB, voffB); PG8_STAGE(PG8_SB(0, 1), cB + hstepB, voffB); PG8_STAGE(PG8_SA(0, 0), cA, voffA); PG8_STAGE(PG8_SA(0, 1), cA + hstepA, voffA);
    if (wr == 1) PG8_BAR;
    PG8_WAIT_V(2); PG8_BAR;
    PG8_STAGE(PG8_SB(1, 0), cB + kstep, voffB); PG8_STAGE(PG8_SA(1, 0), cA + kstep, voffA); PG8_STAGE(PG8_SB(1, 1), cB + hstepB + kstep, voffB);
    PG8_WAIT_V(6); PG8_BAR;
    for (;;) {
        const bool has_next = S.next(ui + 1, nxt);
        unsigned ngA = 0u, ngB = 0u; if constexpr (SEG3) { if (has_next) { ngA = Epi::segA(nxt.seg); ngB = Epi::segB(nxt.seg); } }
        const char* nA = has_next ? (const char*)g.A + (size_t)nxt.pm * tstepA + ngA : cA; const char* nB = has_next ? (const char*)g.Bt + (size_t)nxt.pn * tstepB + ngB : cB;
        for (int t = 0; t < nt; t += 2) {
            const bool last = (t == nt - 2);
            const char* a1 = cA + (size_t)(t + 1) * kstep;
            const char* a2 = last ? nA : cA + (size_t)(t + 2) * kstep; const char* b2 = last ? nB : cB + (size_t)(t + 2) * kstep;
            const char* a3 = a2 + kstep; const char* b3 = b2 + kstep;
            PG8_LDB(B0, 0, 0); PG8_LDB(B1, 0, 1); PG8_SCHED; PG8_LDA(At, 0, 0); PG8_STAGE(PG8_SA(1, 1), a1 + hstepA, voffA);
            PG8_WAIT_V(8); PG8_WAIT_L(0); PG8_BAR; PG8_MMA(0, 0, At, B0); PG8_MMA(0, 1, At, B1); PG8_BAR; PG8_SCHED;
            PG8_LDA(At, 0, 1); PG8_STAGE(PG8_SB(0, 0), b2, voffB); PG8_STAGE(PG8_SB(0, 1), b2 + hstepB, voffB); PG8_STAGE(PG8_SA(0, 0), a2, voffA);
            PG8_WAIT_V(8); PG8_WAIT_L(0); PG8_BAR; PG8_MMA(1, 0, At, B0); PG8_MMA(1, 1, At, B1); PG8_BAR; PG8_SCHED;
            PG8_LDB(B0, 1, 0); PG8_LDB(B1, 1, 1); PG8_SCHED; PG8_LDA(At, 1, 0); PG8_STAGE(PG8_SA(0, 1), a2 + hstepA, voffA);
            PG8_WAIT_V(8); PG8_WAIT_L(0); PG8_BAR; PG8_MMA(0, 0, At, B0); PG8_MMA(0, 1, At, B1); PG8_BAR; PG8_SCHED;
            PG8_LDA(At, 1, 1); PG8_STAGE(PG8_SB(1, 0), b3, voffB); PG8_STAGE(PG8_SB(1, 1), b3 + hstepB, voffB); PG8_STAGE(PG8_SA(1, 0), a3, voffA);
            PG8_WAIT_V(8); PG8_WAIT_L(0); PG8_BAR; PG8_MMA(1, 0, At, B0); PG8_MMA(1, 1, At, B1); PG8_BAR; PG8_SCHED;
        }
        if (wr == 0) PG8_BAR;
        { int t_e = lane_id_v(); asm volatile("" : "+v"(t_e));
          if constexpr (Epi::PF) { if (has_next) E.prefetch(lds, nxt, (ui + 1) % 3, wid, lane);
              E(acc, cur, wr, wc, t_e & 15, (t_e >> 4) & 3, lds, ui % 3); }
          else E(acc, cur, wr, wc, t_e & 15, (t_e >> 4) & 3); }
        if (!has_next) break;
        if (!SEG3 || cur.seg == 2) {
#pragma unroll
        for (int a = 0; a < 2; ++a)
#pragma unroll
            for (int b = 0; b < 2; ++b)
#pragma unroll
                for (int m = 0; m < 4; ++m)
#pragma unroll
                    for (int n = 0; n < 2; ++n) acc[a][b][m][n] = (f32x4){0.f, 0.f, 0.f, 0.f};
        }
        cur = nxt; cA = nA; cB = nB; ++ui;
        if (wr == 1) PG8_BAR;
    }
    PG8_WAIT_V(0);
    PG8_BAR;
#undef PG8_SA
#undef PG8_SB
#undef PG8_STAGE
#undef PG8_LDA
#undef PG8_LDB
#undef PG8_MMA
#undef PG8_WAIT_V
#undef PG8_WAIT_L
#undef PG8_BAR
#undef PG8_SCHED
}
}
using pg8::Unit;
typedef f32x4 AccT[2][2][4][2];

constexpr int EPB_OFF = 131072;
struct EpiSwiglu {
    static constexpr bool PF = true;
    bf16_t* O; const float* ss; const float* sw;
    __device__ __forceinline__ void prefetch(LAS unsigned char* lds, const Unit& u, int slot, int wid, int lane) const {
        const float* src = wid < 4 ? ss + u.pm * 256 + wid * 64 + lane : sw + (size_t)mod_index(u.pm * 256) * 6656 + u.pn * 256 + (wid - 4) * 64 + lane;
        __builtin_amdgcn_global_load_lds((const unsigned*)src, (LAS unsigned*)(lds + EPB_OFF + slot * 2048 + wid * 256), 4, 0, 0);
    }
    __device__ __forceinline__ void operator()(AccT& acc, const Unit& u, int wr, int wc, int fr, int fq, LAS unsigned char* lds, int slot) const {
        const int row0 = u.pm * 256 + wr * 64 + fr, col0 = u.pn * 128 + wc * 32 + fq * 8;
        const LAS float* eb = (const LAS float*)(lds + EPB_OFF + slot * 2048);
        const LAS float* swp = eb + 256 + wc * 32 + fq * 8;
        f32x4 sg[2], su[2];
#pragma unroll
        for (int n = 0; n < 2; ++n) { sg[n] = *(const LAS f32x4*)(swp + n * 4); su[n] = *(const LAS f32x4*)(swp + 128 + n * 4); }
#pragma unroll
        for (int ai = 0; ai < 2; ++ai)
#pragma unroll
            for (int m = 0; m < 4; ++m) {
                const int row = row0 + ai * 128 + m * 16;
                const float rstd = rsqrtf(eb[ai * 128 + wr * 64 + m * 16 + fr] * (1.f / D) + EPS);
                float r[8];
#pragma unroll
                for (int n = 0; n < 2; ++n)
#pragma unroll
                    for (int j = 0; j < 4; ++j) { const float gt = rstd * acc[ai][0][m][n][j] + sg[n][j], up = rstd * acc[ai][1][m][n][j] + su[n][j]; r[n * 4 + j] = gt * sigmoidf_(gt) * up; }
                u32x4 w; w.x = cvt_pk_bf16(r[0], r[1]); w.y = cvt_pk_bf16(r[2], r[3]); w.z = cvt_pk_bf16(r[4], r[5]); w.w = cvt_pk_bf16(r[6], r[7]);
                *(u32x4*)(O + (size_t)row * FF + col0) = w;
            }
    }
};
template <bool FIN> struct EpiResidT {
    static constexpr bool PF = false;
    float* X; unsigned char* ws; float coef;
    int gate_off;
    int ss_slot;
    int gn_off;
    int sc_off;
    __device__ __forceinline__ void operator()(AccT& acc, const Unit& u, int wr, int wc, int fr, int fq) const {
        const int row0 = u.pm * 256 + wr * 64 + fr, col0 = u.pn * 256 + wc * 32 + fq * 8, lane = fq * 16 + fr;
        const int mb = mod_index(u.pm * 256);
        constexpr bool fin = FIN;
        const float* MODp = (const float*)(ws + WS_MOD);
        const float* gp = MODp + gate_off + (size_t)mb * 9216 + col0;
        float* ss = (float*)(ws + WS_SS) + (size_t)ss_slot * M;
        bf16_t* Hout = gn_off >= 0 ? (bf16_t*)(ws + WS_H) : nullptr;
        const float* gn = (const float*)(ws + WS_NG) + (gn_off >= 0 ? gn_off : 0);
        const float* scn = MODp + sc_off;
        f32x4 gv[2][2], av[2][2];
#pragma unroll
        for (int bj = 0; bj < 2; ++bj)
#pragma unroll
            for (int n = 0; n < 2; ++n) {
                gv[bj][n] = *(const f32x4*)(gp + bj * 128 + n * 4) * coef;
                av[bj][n] = (f32x4){0.f, 0.f, 0.f, 0.f};
                if (Hout) av[bj][n] = *(const f32x4*)(gn + col0 + bj * 128 + n * 4) * (*(const f32x4*)(scn + (size_t)mb * 9216 + col0 + bj * 128 + n * 4) + 1.f);
            }
#pragma unroll
        for (int ai = 0; ai < 2; ++ai) {
#pragma unroll
          for (int mp = 0; mp < 2; ++mp) {
            f32x4 xin[4][2][2];
#pragma unroll
            for (int m = 2 * mp; m < 2 * mp + 2; ++m)
#pragma unroll
                for (int bj = 0; bj < 2; ++bj)
#pragma unroll
                    for (int n = 0; n < 2; ++n) xin[m][bj][n] = *(const f32x4*)(X + (size_t)(row0 + ai * 128 + m * 16) * D + col0 + bj * 128 + n * 4);
#pragma unroll
            for (int m = 2 * mp; m < 2 * mp + 2; ++m) {
                const int row = row0 + ai * 128 + m * 16;
                float* xr = X + (size_t)row * D + col0;
                float ssum = 0.f;
#pragma unroll
                for (int bj = 0; bj < 2; ++bj) {
                    f32x4 xv[2];
#pragma unroll
                    for (int n = 0; n < 2; ++n) { f32x4* p = (f32x4*)(xr + bj * 128 + n * 4); f32x4 x = xin[m][bj][n]; x = x + gv[bj][n] * acc[ai][bj][m][n]; if constexpr (FIN) acc[ai][bj][m][n] = x; else *p = x; xv[n] = x;
                        ssum += (x[0] * x[0] + x[1] * x[1]) + (x[2] * x[2] + x[3] * x[3]); }
                    if (Hout) { const f32x4 h0 = xv[0] * av[bj][0], h1 = xv[1] * av[bj][1];
                        u32x4 w; w.x = cvt_pk_bf16(h0[0], h0[1]); w.y = cvt_pk_bf16(h0[2], h0[3]); w.z = cvt_pk_bf16(h1[0], h1[1]); w.w = cvt_pk_bf16(h1[2], h1[3]);
                        *(u32x4*)(Hout + (size_t)row * D + col0 + bj * 128) = w; }
                }
                ssum += shfl_x(ssum, 16, lane); ssum += shfl_x(ssum, 32, lane);
                if (fq == 0) unsafeAtomicAdd(ss + row, ssum);
            }
          }
        }
        if constexpr (FIN) {
            asm volatile("s_waitcnt vmcnt(0)" ::: "memory");
            __syncthreads();
            if (wr == 0 && wc == 0 && lane == 0) {
                unsigned* cnt = (unsigned*)(ws + WS_CNT) + u.pm * 64;
                (void)__hip_atomic_fetch_add(cnt, 1u, __ATOMIC_RELEASE, __HIP_MEMORY_SCOPE_AGENT);
                unsigned sp = 0u;
                while (__hip_atomic_load(cnt, __ATOMIC_ACQUIRE, __HIP_MEMORY_SCOPE_AGENT) < 4u && sp < (1u << 22)) { __builtin_amdgcn_s_sleep(1); ++sp; }
            }
            __syncthreads();
            const float* fg = (const float*)(ws + WS_FG) + col0;
            f32x4 fv[2][2];
#pragma unroll
            for (int bj = 0; bj < 2; ++bj)
#pragma unroll
                for (int n = 0; n < 2; ++n) fv[bj][n] = *(const f32x4*)(fg + bj * 128 + n * 4);
            float rsv[2][4];
#pragma unroll
            for (int ai = 0; ai < 2; ++ai)
#pragma unroll
                for (int m = 0; m < 4; ++m) rsv[ai][m] = __hip_atomic_load(ss + row0 + ai * 128 + m * 16, __ATOMIC_RELAXED, __HIP_MEMORY_SCOPE_AGENT);
#pragma unroll
            for (int ai = 0; ai < 2; ++ai)
#pragma unroll
                for (int m = 0; m < 4; ++m) {
                    const int row = row0 + ai * 128 + m * 16;
                    const float rstd = rsqrtf(rsv[ai][m] * (1.f / D) + EPS);
                    float* xr = X + (size_t)row * D + col0;
#pragma unroll
                    for (int bj = 0; bj < 2; ++bj)
#pragma unroll
                        for (int n = 0; n < 2; ++n) *(f32x4*)(xr + bj * 128 + n * 4) = acc[ai][bj][m][n] * rstd * fv[bj][n];
                }
        }
    }
};
struct EpiIn {
    static constexpr bool PF = true;
    bf16_t* U; float* out; int l; const float* ss; const float* sw;
    __device__ __forceinline__ void prefetch(LAS unsigned char* lds, const Unit& u, int slot, int wid, int lane) const {
        const float* src = wid < 4 ? ss + u.pm * 256 + wid * 64 + lane : sw + (size_t)mod_index(u.pm * 256) * 6656 + u.pn * 256 + (wid - 4) * 64 + lane;
        __builtin_amdgcn_global_load_lds((const unsigned*)src, (LAS unsigned*)(lds + EPB_OFF + slot * 2048 + wid * 256), 4, 0, 0);
    }
    __device__ __forceinline__ void operator()(AccT& acc, const Unit& u, int wr, int wc, int fr, int fq, LAS unsigned char* lds, int slot) const {
        const int row0 = u.pm * 256 + wr * 64 + fr, col0 = u.pn * 256 + wc * 32 + fq * 8;
        const LAS float* eb = (const LAS float*)(lds + EPB_OFF + slot * 2048);
        const LAS float* swp = eb + 256 + wc * 32 + fq * 8;
        f32x4 sv[2][2];
#pragma unroll
        for (int bj = 0; bj < 2; ++bj)
#pragma unroll
            for (int n = 0; n < 2; ++n) sv[bj][n] = *(const LAS f32x4*)(swp + bj * 128 + n * 4);
        const bool prm = u.pm < 32;
        const int b = u.pm;
        const bool kv = prm && u.pn >= 8 && u.pn < 12, kr = prm && u.pn == 13 && wc == 0;
        float* cbase = out + (u.pn < 10 ? OUT_NK : OUT_NV);
        const int hq = (u.pn & 1) * 4;
#pragma unroll
        for (int ai = 0; ai < 2; ++ai)
#pragma unroll
            for (int m = 0; m < 4; ++m) {
                const int row = row0 + ai * 128 + m * 16, s = ai * 128 + wr * 64 + m * 16 + fr;
                const float rstd = rsqrtf(eb[s] * (1.f / D) + EPS);
#pragma unroll
                for (int bj = 0; bj < 2; ++bj) {
                    const f32x4 v0 = acc[ai][bj][m][0] * rstd + sv[bj][0], v1 = acc[ai][bj][m][1] * rstd + sv[bj][1];
                    u32x4 w; w.x = cvt_pk_bf16(v0[0], v0[1]); w.y = cvt_pk_bf16(v0[2], v0[3]); w.z = cvt_pk_bf16(v1[0], v1[1]); w.w = cvt_pk_bf16(v1[2], v1[3]);
                    *(u32x4*)(U + (size_t)row * UN + col0 + bj * 128) = w;
                    if (kv) { const int h = hq + bj * 2 + (wc >> 1), d0 = (wc & 1) * 32 + fq * 8;
                        float* hb = cbase + ((size_t)((b * 2 + l) * 8 + h) * 256 + s) * 64 + d0;
                        *(f32x4*)hb = v0; *(f32x4*)(hb + 4) = v1; }
                    if (kr && bj == 1) { float* kb = out + OUT_KR + ((size_t)(b * 2 + l) * 256 + s) * 32 + fq * 8;
                        *(f32x4*)kb = v0; *(f32x4*)(kb + 4) = v1; }
                }
            }
    }
};
struct EpiQ {
    static constexpr bool PF = false;
    bf16_t* U; const f32x2* rope;
    __device__ __forceinline__ void operator()(AccT& acc, const Unit& u, int wr, int wc, int fr, int fq) const {
        const int row0 = u.pm * 256 + wr * 64 + fr, col0 = u.pn * 256 + wc * 32 + fq * 8;
        const bool sample = u.pm >= 32;
#pragma unroll
        for (int ai = 0; ai < 2; ++ai)
#pragma unroll
            for (int m = 0; m < 4; ++m) {
                const int row = row0 + ai * 128 + m * 16;
                const int s = (row - MP) & 1023, grow = s >> 6, gcol = s & 63;
#pragma unroll
                for (int bj = 0; bj < 2; ++bj) {
                    float v[8];
#pragma unroll
                    for (int n = 0; n < 2; ++n)
#pragma unroll
                        for (int j = 0; j < 4; ++j) v[n * 4 + j] = acc[ai][bj][m][n][j];
                    if (sample) {
                        const int cb = (col0 + bj * 128) % 96;
                        const bool isr = cb >= 64;
                        const int pos = (cb >= 80) ? gcol : grow;
                        const bool second = ((cb >> 3) & 1) != 0;
#pragma unroll
                        for (int i = 0; i < 8; ++i) {
                            const float pr = shfl_x(v[i], 16, fq * 16 + fr);
                            const f32x2 cs = rope[pos * 8 + i];
                            const float o = second ? (pr * cs.y + v[i] * cs.x) : (v[i] * cs.x - pr * cs.y);
                            v[i] = isr ? o : v[i];
                        }
                    }
                    u32x4 w; w.x = cvt_pk_bf16(v[0], v[1]); w.y = cvt_pk_bf16(v[2], v[3]); w.z = cvt_pk_bf16(v[4], v[5]); w.w = cvt_pk_bf16(v[6], v[7]);
                    *(u32x4*)(U + (size_t)row * UN + UC_QM + col0 + bj * 128) = w;
                }
            }
    }
};
struct EpiPlain {
    static constexpr bool PF = false;
    bf16_t* O; int ldc;
    __device__ __forceinline__ void operator()(AccT& acc, const Unit& u, int wr, int wc, int fr, int fq) const {
        const int row0 = u.pm * 256 + wr * 64 + fr, col0 = u.pn * 256 + wc * 32 + fq * 8;
#pragma unroll
        for (int ai = 0; ai < 2; ++ai)
#pragma unroll
            for (int m = 0; m < 4; ++m)
#pragma unroll
                for (int bj = 0; bj < 2; ++bj) {
                    const f32x4 v0 = acc[ai][bj][m][0], v1 = acc[ai][bj][m][1];
                    u32x4 w; w.x = cvt_pk_bf16(v0[0], v0[1]); w.y = cvt_pk_bf16(v0[2], v0[3]); w.z = cvt_pk_bf16(v1[0], v1[1]); w.w = cvt_pk_bf16(v1[2], v1[3]);
                    *(u32x4*)(O + (size_t)(row0 + ai * 128 + m * 16) * ldc + col0 + bj * 128) = w;
                }
    }
};
struct EpiZ3 {
    static constexpr bool PF = false;
    bf16_t* U;
    static __device__ __forceinline__ unsigned segA(int seg) { return (unsigned)(seg == 0 ? UC_YC : (seg == 1 ? UC_ONA : UC_OM)) * 2u; }
    static __device__ __forceinline__ unsigned segB(int seg) { return (unsigned)seg * (1024u * 512u * 2u); }
    static __device__ __forceinline__ float en(float x) { return __builtin_amdgcn_exp2f(-fminf(fmaxf(x, -30.f), 30.f) * LOG2E); }
    __device__ __forceinline__ void operator()(AccT& acc, const Unit& u, int wr, int wc, int fr, int fq) const {
        const int row0 = u.pm * 256 + wr * 64 + fr, col0 = u.pn * 256 + wc * 32 + fq * 8;
        const int seg = u.seg;
        const int sga = (seg < 2 ? seg : 2) * 1024, sgb = (seg < 2 ? seg + 1 : 2) * 1024;
#pragma unroll
        for (int ai = 0; ai < 2; ++ai)
#pragma unroll
          for (int mp = 0; mp < 2; ++mp) {
            u32x4 gA[2][2], gB[2][2];
#pragma unroll
            for (int mm = 0; mm < 2; ++mm)
#pragma unroll
                for (int bj = 0; bj < 2; ++bj) {
                    const bf16_t* ur_ = U + (size_t)(row0 + ai * 128 + (2 * mp + mm) * 16) * UN + UC_G + col0 + bj * 128;
                    gA[mm][bj] = *(const u32x4*)(ur_ + sga); gB[mm][bj] = *(const u32x4*)(ur_ + sgb);
                }
#pragma unroll
            for (int mm = 0; mm < 2; ++mm) {
                const int m = 2 * mp + mm;
                bf16_t* ur = U + (size_t)(row0 + ai * 128 + m * 16) * UN;
#pragma unroll
                for (int bj = 0; bj < 2; ++bj) {
                    const int col = col0 + bj * 128;
                    float f[8];
                    if (seg < 2) {
                        const u32x4 ga = gA[mm][bj], gb = gB[mm][bj];
#pragma unroll
                        for (int q = 0; q < 4; ++q) {
                            f[2 * q] = (1.f + en(bf_lo(gb[q]))) * __builtin_amdgcn_rcpf(1.f + en(bf_lo(ga[q])));
                            f[2 * q + 1] = (1.f + en(bf_hi(gb[q]))) * __builtin_amdgcn_rcpf(1.f + en(bf_hi(ga[q])));
                        }
                    } else {
                        const u32x4 ga = gA[mm][bj];
#pragma unroll
                        for (int q = 0; q < 4; ++q) { f[2 * q] = __builtin_amdgcn_rcpf(1.f + en(bf_lo(ga[q]))); f[2 * q + 1] = __builtin_amdgcn_rcpf(1.f + en(bf_hi(ga[q]))); }
                    }
#pragma unroll
                    for (int n = 0; n < 2; ++n)
#pragma unroll
                        for (int j = 0; j < 4; ++j) acc[ai][bj][m][n][j] *= f[n * 4 + j];
                    if (seg == 2) {
                        const f32x4 v0 = acc[ai][bj][m][0], v1 = acc[ai][bj][m][1];
                        u32x4 w; w.x = cvt_pk_bf16(v0[0], v0[1]); w.y = cvt_pk_bf16(v0[2], v0[3]); w.z = cvt_pk_bf16(v1[0], v1[1]); w.w = cvt_pk_bf16(v1[2], v1[3]);
                        *(u32x4*)(ur + UC_Z + col) = w;
                    }
                }
            }
          }
    }
};

struct AttnSeg { unsigned k1, k2, v; int ldk1, ldk2, ldv, nkeys; };

template <int DQK, bool NAL>
__device__ __forceinline__ void attn_unit(LAS unsigned char* lds, const int tid, const unsigned char* wsb, const bf16_t* Q, int ldq, bf16_t* O, int ldo, const AttnSeg s0, const AttnSeg s1,
                                          float sc_log2, int qrow0, int rb0, const float* rpb_h) {
    constexpr int KSTR = (DQK + 8) * 2, VSTR = 144, CPR = DQK / 8, NKS = DQK / 32, NQ = 2;
    const int w = __builtin_amdgcn_readfirstlane(tid >> 6), lane = tid & 63, fr = lane & 15, fq = lane >> 4;
    LAS unsigned char* Kt = lds;
    LAS unsigned char* Vt = lds + 16384;
    LAS float* biasL = (LAS float*)(lds + 32768);
    __syncthreads();
    if (NAL) { for (int i = tid; i < 15 * 31; i += 512) biasL[i] = rpb_h[i] * LOG2E; }
    bf16x8 qf[NQ][NKS];
#pragma unroll
    for (int qi = 0; qi < NQ; ++qi) { const bf16_t* qr = Q + (size_t)(32 * w + 16 * qi + fr) * ldq + fq * 8;
#pragma unroll
      for (int ks = 0; ks < NKS; ++ks) qf[qi][ks] = *(const bf16x8*)(qr + ks * 32); }
    f32x4 ot[NQ][4];
    float mrun[NQ], lsum[NQ];
#pragma unroll
    for (int qi = 0; qi < NQ; ++qi) { unsigned ni_ = 0xff800000u, z_ = 0u; asm volatile("" : "+v"(ni_), "+v"(z_));
        mrun[qi] = __builtin_bit_cast(float, ni_); lsum[qi] = __builtin_bit_cast(float, z_);
#pragma unroll
        for (int c = 0; c < 4; ++c) ot[qi][c] = (f32x4){0.f, 0.f, 0.f, 0.f}; }
    const int T0 = s0.nkeys >> 6, T = T0 + (s1.nkeys >> 6);
    const int kr0 = tid / CPR, kc0 = tid % CPR;
    const int kr1 = (tid + 512) / CPR, kc1 = (tid + 512) % CPR;
    const bool has2 = (DQK == 96) && (tid < 256);
    const int vr = tid >> 3, vc = tid & 7;
    u32x4 rk0[4], rk1[4], rv[4];
#pragma unroll
    for (int s_ = 0; s_ < 4; ++s_) rk1[s_] = (u32x4){0u, 0u, 0u, 0u};
    const unsigned pa0 = (kc0 < 8) ? s0.k1 + (unsigned)(kr0 * s0.ldk1 + kc0 * 8) * 2u : s0.k2 + (unsigned)(kr0 * s0.ldk2 + (kc0 - 8) * 8) * 2u;
    const unsigned pb0 = (kc0 < 8) ? s1.k1 + (unsigned)(kr0 * s1.ldk1 + kc0 * 8) * 2u : s1.k2 + (unsigned)(kr0 * s1.ldk2 + (kc0 - 8) * 8) * 2u;
    const unsigned sa0 = (unsigned)((kc0 < 8) ? s0.ldk1 : s0.ldk2) * 128u, sb0 = (unsigned)((kc0 < 8) ? s1.ldk1 : s1.ldk2) * 128u;
    const unsigned pa1 = (kc1 < 8) ? s0.k1 + (unsigned)(kr1 * s0.ldk1 + kc1 * 8) * 2u : s0.k2 + (unsigned)(kr1 * s0.ldk2 + (kc1 - 8) * 8) * 2u;
    const unsigned pb1 = (kc1 < 8) ? s1.k1 + (unsigned)(kr1 * s1.ldk1 + kc1 * 8) * 2u : s1.k2 + (unsigned)(kr1 * s1.ldk2 + (kc1 - 8) * 8) * 2u;
    const unsigned sa1 = (unsigned)((kc1 < 8) ? s0.ldk1 : s0.ldk2) * 128u, sb1 = (unsigned)((kc1 < 8) ? s1.ldk1 : s1.ldk2) * 128u;
    const unsigned pav = s0.v + (unsigned)(vr * s0.ldv + vc * 8) * 2u, pbv = s1.v + (unsigned)(vr * s1.ldv + vc * 8) * 2u;
    const unsigned sav = (unsigned)s0.ldv * 128u, sbv = (unsigned)s1.ldv * 128u;
#define ATT_LOAD(ti, S_) do { const bool f_ = (ti) < T0; const unsigned t_ = (unsigned)(f_ ? (ti) : (ti) - T0); \
        rk0[S_] = *(const u32x4*)(wsb + (size_t)((f_ ? pa0 : pb0) + t_ * (f_ ? sa0 : sb0))); \
        if (has2) rk1[S_] = *(const u32x4*)(wsb + (size_t)((f_ ? pa1 : pb1) + t_ * (f_ ? sa1 : sb1))); \
        rv[S_] = *(const u32x4*)(wsb + (size_t)((f_ ? pav : pbv) + t_ * (f_ ? sav : sbv))); } while (0)
#pragma unroll
    for (int s_ = 0; s_ < 4; ++s_) { if (s_ < T) ATT_LOAD(s_, s_); }
    const int qrow = qrow0 + (w >> 1);
    const int qc0 = ((32 * w) & 63) + fr;
    const int bstart = min(max(qrow - 4, 0), 8);
    int dcv[NQ][16]; unsigned vmask[NQ];
#pragma unroll
    for (int qi = 0; qi < NQ; ++qi) {
        vmask[qi] = 0u;
        if (NAL) {
            const int qcol = qc0 + 16 * qi, cs = min(max(qcol - 8, 0), 48);
#pragma unroll
            for (int i = 0; i < 16; ++i) {
                const int kcol = 16 * (i >> 2) + 4 * fq + (i & 3), rel = kcol - cs;
                dcv[qi][i] = min(max(kcol - qcol + 15, 0), 30);
                vmask[qi] |= (rel >= 0 && rel < 16) ? (1u << i) : 0u;
            }
        } else {
#pragma unroll
            for (int i = 0; i < 16; ++i) dcv[qi][i] = 0;
        }
    }
#define ATT_BAR() do { asm volatile("s_waitcnt lgkmcnt(0)" ::: "memory"); __builtin_amdgcn_s_barrier(); asm volatile("" ::: "memory"); } while (0)
    for (int tb = 0; tb < T; tb += 4) {
#pragma unroll
      for (int s_ = 0; s_ < 4; ++s_) {
        const int ti = tb + s_;
        if (ti >= T) break;
        ATT_BAR();
        *(LAS u32x4*)(Kt + kr0 * KSTR + kc0 * 16) = rk0[s_];
        if (has2) *(LAS u32x4*)(Kt + kr1 * KSTR + kc1 * 16) = rk1[s_];
        *(LAS u32x4*)(Vt + vr * VSTR + vc * 16) = rv[s_];
        ATT_BAR();
        if (ti + 4 < T) ATT_LOAD(ti + 4, s_);
        const bool local = NAL && (ti >= T0);
        const int krow = rb0 + (ti - T0);
        if (!(local && (krow < bstart || krow >= bstart + 8))) {
        f32x4 st[NQ][4];
#pragma unroll
        for (int kb = 0; kb < 4; ++kb) {
#pragma unroll
            for (int qi = 0; qi < NQ; ++qi) st[qi][kb] = (f32x4){0.f, 0.f, 0.f, 0.f};
#pragma unroll
            for (int ks = 0; ks < NKS; ++ks) {
                const bf16x8 kf = *(const LAS bf16x8*)(Kt + (16 * kb + fr) * KSTR + (32 * ks + 8 * fq) * 2);
#pragma unroll
                for (int qi = 0; qi < NQ; ++qi) st[qi][kb] = __builtin_amdgcn_mfma_f32_16x16x32_bf16(kf, qf[qi][ks], st[qi][kb], 0, 0, 0);
            }
        }
        bf16x8 pa[NQ][2];
#pragma unroll
        for (int qi = 0; qi < NQ; ++qi) {
            float mx = -INFINITY;
            if (local) {
                const LAS float* brow = biasL + (krow - qrow + 7) * 31;
#pragma unroll
                for (int kb = 0; kb < 4; ++kb)
#pragma unroll
                    for (int j = 0; j < 4; ++j) {
                        const float bb = brow[dcv[qi][kb * 4 + j]];
                        const float t = ((vmask[qi] >> (kb * 4 + j)) & 1u) ? st[qi][kb][j] * sc_log2 + bb : -1e30f;
                        st[qi][kb][j] = t; mx = fmaxf(mx, t);
                    }
            } else {
#pragma unroll
                for (int kb = 0; kb < 4; ++kb)
#pragma unroll
                    for (int j = 0; j < 4; ++j) { const float t = st[qi][kb][j] * sc_log2; st[qi][kb][j] = t; mx = fmaxf(mx, t); }
            }
            mx = fmaxf(mx, shfl_x(mx, 16, lane)); mx = fmaxf(mx, shfl_x(mx, 32, lane));
            const float mold = mrun[qi], mnew = fmaxf(mold, mx);
            mrun[qi] = mnew;
            float ps = 0.f;
#pragma unroll
            for (int kb = 0; kb < 4; ++kb)
#pragma unroll
                for (int j = 0; j < 4; ++j) { const float p = __builtin_amdgcn_exp2f(st[qi][kb][j] - mnew); st[qi][kb][j] = p; ps += p; }
            if (__builtin_amdgcn_ballot_w64(mnew > mold) != 0ull) {
                const float alpha = __builtin_amdgcn_exp2f(mold - mnew);
                lsum[qi] *= alpha;
#pragma unroll
                for (int c = 0; c < 4; ++c) ot[qi][c] = ot[qi][c] * alpha;
            }
            lsum[qi] += ps;
#pragma unroll
            for (int ks2 = 0; ks2 < 2; ++ks2) {
                u32x4 pw; pw.x = cvt_pk_bf16(st[qi][2 * ks2][0], st[qi][2 * ks2][1]); pw.y = cvt_pk_bf16(st[qi][2 * ks2][2], st[qi][2 * ks2][3]);
                pw.z = cvt_pk_bf16(st[qi][2 * ks2 + 1][0], st[qi][2 * ks2 + 1][1]); pw.w = cvt_pk_bf16(st[qi][2 * ks2 + 1][2], st[qi][2 * ks2 + 1][3]);
                pa[qi][ks2] = __builtin_bit_cast(bf16x8, pw);
            }
        }
#pragma unroll
        for (int ks2 = 0; ks2 < 2; ++ks2)
#pragma unroll
            for (int c = 0; c < 4; ++c) {
                LAS unsigned char* vb = Vt + (32 * ks2 + 4 * fq + (fr >> 2)) * VSTR + (16 * c + 4 * (fr & 3)) * 2;
                const s16x4 v0 = __builtin_amdgcn_ds_read_tr16_b64_v4i16((LAS s16x4*)vb);
                const s16x4 v1 = __builtin_amdgcn_ds_read_tr16_b64_v4i16((LAS s16x4*)(vb + 16 * VSTR));
                bf16x8 vf; vf[0] = v0[0]; vf[1] = v0[1]; vf[2] = v0[2]; vf[3] = v0[3]; vf[4] = v1[0]; vf[5] = v1[1]; vf[6] = v1[2]; vf[7] = v1[3];
#pragma unroll
                for (int qi = 0; qi < NQ; ++qi) ot[qi][c] = __builtin_amdgcn_mfma_f32_16x16x32_bf16(vf, pa[qi][ks2], ot[qi][c], 0, 0, 0);
            }
        }
      }
    }
#undef ATT_BAR
#undef ATT_LOAD
#pragma unroll
    for (int qi = 0; qi < NQ; ++qi) {
        float l = lsum[qi];
        l += shfl_x(l, 16, lane); l += shfl_x(l, 32, lane);
        const float inv = 1.f / l;
        bf16_t* orow = O + (size_t)(32 * w + 16 * qi + fr) * ldo + 4 * fq;
#pragma unroll
        for (int c = 0; c < 4; ++c) { u32x2 wv; wv.x = cvt_pk_bf16(ot[qi][c][0] * inv, ot[qi][c][1] * inv); wv.y = cvt_pk_bf16(ot[qi][c][2] * inv, ot[qi][c][3] * inv); *(u32x2*)(orow + 16 * c) = wv; }
    }
}

#define XB_TMO      128
#define XB_XCNT(j)  (256  + 64 * (j))
#define XB_XSUB(j)  (1280 + 64 * (j))
#define XB_XGEN(j)  (2304 + 64 * (j))
#define XB_TOP      3328
#define XB_TOPGEN   3392
#define XCD_BAR_WORDS 3456
#define XB_SPIN_CAP (1u << 22)
__device__ __forceinline__ unsigned xb_ld(unsigned* p)              { return __hip_atomic_load(p, __ATOMIC_RELAXED, __HIP_MEMORY_SCOPE_AGENT); }
__device__ __forceinline__ unsigned xb_add(unsigned* p, unsigned v) { return __hip_atomic_fetch_add(p, v, __ATOMIC_RELAXED, __HIP_MEMORY_SCOPE_AGENT); }
__device__ __forceinline__ unsigned xb_xcc_id() { return (unsigned)__builtin_amdgcn_s_getreg((3 << 11) | 20) & 0xFu; }
#define XB_SPIN(cond, bar) do { unsigned _sp = 0; while (cond) { __builtin_amdgcn_s_sleep(1); \
    if ((++_sp & 255u) == 0u) { if (xb_ld(&(bar)[XB_TMO])) break; if (_sp > XB_SPIN_CAP) { atomicAdd(&(bar)[XB_TMO], 1u); break; } } } } while (0)
struct XcdBarrier { unsigned* bar; unsigned x; volatile LAS unsigned* st; };
__device__ __forceinline__ void xcd_barrier_complete(unsigned* bar, unsigned x, unsigned& nloc, unsigned& nx) {
    const unsigned G = gridDim.x;
    unsigned sum, cnt, mine, sp = 0u;
    for (;;) {
        sum = 0u; cnt = 0u; mine = 0u;
#pragma unroll
        for (unsigned j = 0; j < 16; ++j) { const unsigned c = xb_ld(&bar[XB_XCNT(j)]); sum += c; cnt += (c > 0u) ? 1u : 0u; mine = (j == x) ? c : mine; }
        if (sum == G) break;
        __builtin_amdgcn_s_sleep(1);
        if ((++sp & 255u) == 0u) { if (xb_ld(&bar[XB_TMO])) break; if (sp > XB_SPIN_CAP) { atomicAdd(&bar[XB_TMO], 1u); break; } }
    }
    nloc = mine > 0u ? mine : 1u; nx = cnt > 0u ? cnt : 1u;
}
__device__ __forceinline__ void xcd_barrier(const XcdBarrier& b, const int wave_s) {
    asm volatile("s_waitcnt vmcnt(0)" ::: "memory");
    __syncthreads();
    if (wave_s == 0) { if (lane_id_v() == 0) {
        unsigned* bar = b.bar;
        __builtin_amdgcn_s_waitcnt(0);
        unsigned nloc = b.st[0], nx = b.st[1];
        if (nloc == 0u) { xcd_barrier_complete(bar, b.x, nloc, nx); b.st[0] = nloc; b.st[1] = nx; }
        const unsigned old = xb_add(&bar[XB_XSUB(b.x)], 1u);
        const unsigned gen = old / nloc;
        if (old + 1u == (gen + 1u) * nloc) {
            __builtin_amdgcn_fence(__ATOMIC_RELEASE, "agent");
            asm volatile("s_waitcnt vmcnt(0)" ::: "memory");
            const unsigned og = xb_add(&bar[XB_TOP], 1u);
            const unsigned tg = og / nx;
            if (og + 1u == (tg + 1u) * nx) xb_add(&bar[XB_TOPGEN], 1u);
            else XB_SPIN(xb_ld(&bar[XB_TOPGEN]) == tg, bar);
            __builtin_amdgcn_fence(__ATOMIC_ACQUIRE, "agent");
            xb_add(&bar[XB_XGEN(b.x)], 1u);
            asm volatile("s_waitcnt vmcnt(0)" ::: "memory");
        } else {
            XB_SPIN(xb_ld(&bar[XB_XGEN(b.x)]) == gen, bar);
            __builtin_amdgcn_fence(__ATOMIC_ACQUIRE, "agent");
            asm volatile("s_waitcnt vmcnt(0)" ::: "memory");
        }
    } }
    __syncthreads();
}

__device__ __forceinline__ const float* ldptr(const unsigned long long* tab, int i) {
    const unsigned long long v = tab[i];
    const unsigned lo = __builtin_amdgcn_readfirstlane((unsigned)v), hi = __builtin_amdgcn_readfirstlane((unsigned)(v >> 32));
    return (const float*)(((unsigned long long)hi << 32) | lo);
}
struct Params { const float* in[30]; float* out; unsigned char* ws; int ph_lo, ph_hi; };

__device__ __forceinline__ void transpose_item(const float* W, int K, int N, bf16_t* WT, int map, LAS float* scr, int item, int lane, const float* shp = nullptr, float* swp = nullptr) {
    const int nblk = (N + 63) >> 6, kb = item / nblk, nb = item - kb * nblk, k0 = 64 * kb, n0 = 64 * nb;
    const int lc = 4 * (lane & 15), lr = lane >> 4;
    const bool okc = n0 + lc < N;
    f32x4 v[16];
#pragma unroll
    for (int i = 0; i < 16; ++i) v[i] = okc ? *(const f32x4*)(W + (size_t)(k0 + 4 * i + lr) * N + n0 + lc) : (f32x4){0.f, 0.f, 0.f, 0.f};
#pragma unroll
    for (int i = 0; i < 16; ++i) { LAS float* d = scr + (4 * i + lr) * 65 + lc; d[0] = v[i][0]; d[1] = v[i][1]; d[2] = v[i][2]; d[3] = v[i][3]; }
    asm volatile("s_waitcnt lgkmcnt(0)" ::: "memory");
    if (shp) {
        float shv[9], pacc[9];
#pragma unroll
        for (int mb = 0; mb < 9; ++mb) { shv[mb] = shp[(size_t)mb * 9216 + k0 + lane]; pacc[mb] = 0.f; }
#pragma unroll 8
        for (int kk = 0; kk < 64; ++kk) {
            const float w = scr[kk * 65 + lane];
#pragma unroll
            for (int mb = 0; mb < 9; ++mb) pacc[mb] += __builtin_bit_cast(float, __builtin_amdgcn_readlane(__builtin_bit_cast(int, shv[mb]), kk)) * w;
        }
        const int ng = n0 + lane; int r = ng;
        if (map == 1) r = (ng >> 7) * 256 + (ng & 127); else if (map == 2) r = (ng >> 7) * 256 + 128 + (ng & 127); else if (map == 3) r = ng >= 3488 ? ng + 96 : ng;
        if (ng < N) {
#pragma unroll
            for (int mb = 0; mb < 9; ++mb) unsafeAtomicAdd(swp + (size_t)mb * 6656 + r, pacc[mb]);
        }
    }
    const int c = lane & 7;
#pragma unroll
    for (int j = 0; j < 8; ++j) { const int n = (lane >> 3) + 8 * j; const LAS float* sp = scr + (8 * c) * 65 + n;
        u32x4 o; o.x = cvt_pk_bf16(sp[0 * 65], sp[1 * 65]); o.y = cvt_pk_bf16(sp[2 * 65], sp[3 * 65]); o.z = cvt_pk_bf16(sp[4 * 65], sp[5 * 65]); o.w = cvt_pk_bf16(sp[6 * 65], sp[7 * 65]);
        const int ng = n0 + n; int r = ng;
        if (map == 1) r = (ng >> 7) * 256 + (ng & 127); else if (map == 2) r = (ng >> 7) * 256 + 128 + (ng & 127); else if (map == 3) r = ng >= 3488 ? ng + 96 : ng;
        if (ng < N) *(u32x4*)(WT + (size_t)r * K + k0 + 8 * c) = o; }
    asm volatile("s_waitcnt lgkmcnt(0)" ::: "memory");
}

constexpr int CV_IF = 16 * 44, CV_NIT = 6 * (16 * 44) + 16 * 103 + 4 * 12 + 2 * 16 + 3 * (8 * 16) + 16 * 16;
#define CONVERT_RANGE(LL, IT0, ITEND) \
                { \
                    LAS float* scr = (LAS float*)(lds + wave * 16640); const float* MODL_ = MOD + (size_t)(LL) * 9 * 9216; float* SWL_ = SW + (size_t)(LL) * 27 * 6656; \
                    constexpr int I_F = 16 * 44, I_IN = 16 * 103, I_UQ = 4 * 12, I_UKV = 2 * 16, I_B = 8 * 16, I_O = 16 * 16; \
                    constexpr int NIT = 6 * I_F + I_IN + I_UQ + I_UKV + 3 * I_B + I_O; \
                    for (int it = (IT0); it < (ITEND); it += NGW) { \
                        int r = it; \
                        if (r < I_F) { transpose_item(ldptr(tab, 11) + (size_t)(LL) * D * FF, D, FF, WB + WO_GU1, 1, scr, r, lane, MODL_ + 0 * 3072, SWL_ + (size_t)0 * 9 * 6656); continue; } r -= I_F; \
                        if (r < I_F) { transpose_item(ldptr(tab, 12) + (size_t)(LL) * D * FF, D, FF, WB + WO_GU1, 2, scr, r, lane, MODL_ + 0 * 3072, SWL_ + (size_t)0 * 9 * 6656); continue; } r -= I_F; \
                        if (r < I_F) { transpose_item(ldptr(tab, 13) + (size_t)(LL) * D * FF, FF, D, WB + WO_D1, 0, scr, r, lane); continue; } r -= I_F; \
                        if (r < I_F) { transpose_item(ldptr(tab, 14) + (size_t)(LL) * D * FF, D, FF, WB + WO_GU2, 1, scr, r, lane, MODL_ + 2 * 3072, SWL_ + (size_t)2 * 9 * 6656); continue; } r -= I_F; \
                        if (r < I_F) { transpose_item(ldptr(tab, 15) + (size_t)(LL) * D * FF, D, FF, WB + WO_GU2, 2, scr, r, lane, MODL_ + 2 * 3072, SWL_ + (size_t)2 * 9 * 6656); continue; } r -= I_F; \
                        if (r < I_IN) { transpose_item(ldptr(tab, 17) + (size_t)(LL) * D * 6560, D, 6560, WB + WO_IN, 3, scr, r, lane, MODL_ + 1 * 3072, SWL_ + (size_t)1 * 9 * 6656); continue; } r -= I_IN; \
                        if (r < I_UQ) { transpose_item(ldptr(tab, 22) + (size_t)(LL) * 256 * 768, 256, 768, WB + WO_UQ, 0, scr, r, lane); continue; } r -= I_UQ; \
                        if (r < I_UKV) { transpose_item(ldptr(tab, 24) + (size_t)(LL) * 128 * 1024, 128, 1024, WB + WO_UKV, 0, scr, r, lane); continue; } r -= I_UKV; \
                        if (r < I_B) { transpose_item(ldptr(tab, 25) + (size_t)(LL) * 512 * D, 512, D, WB + WO_C, 0, scr, r, lane); continue; } r -= I_B; \
                        if (r < I_B) { transpose_item(ldptr(tab, 26) + (size_t)(LL) * 512 * D, 512, D, WB + WO_N, 0, scr, r, lane); continue; } r -= I_B; \
                        if (r < I_B) { transpose_item(ldptr(tab, 27) + (size_t)(LL) * 512 * D, 512, D, WB + WO_M, 0, scr, r, lane); continue; } r -= I_B; \
                        if (r < I_O) { transpose_item(ldptr(tab, 28) + (size_t)(LL) * D * D, D, D, WB + WO_O, 0, scr, r, lane); continue; } r -= I_O; \
                        transpose_item(ldptr(tab, 16) + (size_t)(LL) * D * FF, FF, D, WB + WO_D2, 0, scr, r, lane);     \
                    } \
                }

__global__ void __launch_bounds__(512, 2) fwd_kernel(Params p) {
    extern __shared__ __attribute__((aligned(16))) unsigned char lds_raw[];
    LAS unsigned char* lds = (LAS unsigned char*)lds_raw;
    cg::grid_group grid = cg::this_grid();
    const int G = gridDim.x;
    unsigned char* ws = p.ws;
    float* MOD = (float*)(ws + WS_MOD);
    f32x2* ROPE = (f32x2*)(ws + WS_ROPE);
    bf16_t* WB = (bf16_t*)(ws + WS_W);
    bf16_t* H = (bf16_t*)(ws + WS_H);
    bf16_t* YC = (bf16_t*)(ws + WS_H + HO_YC);
    bf16_t* CQN = (bf16_t*)(ws + WS_H + HO_CQN);
    bf16_t* CKVN = (bf16_t*)(ws + WS_H + HO_CKVN);
    bf16_t* KR = (bf16_t*)(ws + WS_H + HO_KR);
    bf16_t* U = (bf16_t*)(ws + WS_U);
    bf16_t* ACT = U;
    bf16_t* KVX = (bf16_t*)(ws + WS_KVX);
    bf16_t* CK = (bf16_t*)(ws + WS_CK);
    bf16_t* CV = (bf16_t*)(ws + WS_CV);
    float* X = p.out;
    float* SS = (float*)(ws + WS_SS);
    float* SW = (float*)(ws + WS_SW);

    LAS unsigned* stw = (LAS unsigned*)(lds + 139264);
    if (threadIdx.x < 4) stw[threadIdx.x] = 0u;
    __syncthreads();
    unsigned* barw = (unsigned*)(ws + WS_BAR);
    int ph = p.ph_lo;
    const int wave_s = __builtin_amdgcn_readfirstlane(threadIdx.x >> 6);
    const unsigned long long* tab = (const unsigned long long*)(ws + WS_TAB);
    XcdBarrier xb; xb.bar = barw; xb.x = xb_xcc_id(); xb.st = (volatile LAS unsigned*)stw;
    if (threadIdx.x == 0) (void)xb_add(&barw[XB_XCNT(xb.x)], 1u);
    if (ph == 0) {
        {
        int tid = threadIdx.x; asm volatile("" : "+v"(tid));
        int bid = blockIdx.x; asm volatile("" : "+s"(bid));
        const int lane = tid & 63, wave = __builtin_amdgcn_readfirstlane(tid >> 6);
        if (bid == 1) { for (int i = tid; i < 6 * 1024; i += 512) ((float*)(ws + WS_NG))[i] = p.in[10][i]; }
        if (bid == 2) { for (int i = tid; i < 1024; i += 512) ((float*)(ws + WS_FG))[i] = p.in[29][i]; for (int i = tid; i < 64 * 64; i += 512) ((unsigned*)(ws + WS_CNT))[i] = 0u; }
        { f32x4* wz = (f32x4*)SW; for (int i = bid * 512 + tid; i < 2 * 27 * 6656 / 4; i += G * 512) wz[i] = (f32x4){0.f, 0.f, 0.f, 0.f}; }
        { f32x4* sz = (f32x4*)SS; for (int i = bid * 512 + tid; i < 7 * M / 4; i += G * 512) sz[i] = (f32x4){0.f, 0.f, 0.f, 0.f}; }
        if (bid == 0 && tid == 0) {
            unsigned long long* tw = (unsigned long long*)(ws + WS_TAB);
#pragma unroll
            for (int i = 0; i < 30; ++i) tw[i] = (unsigned long long)p.in[i];
        }
        {
            LAS float* sl = (LAS float*)lds;
            LAS f32x2* red = (LAS f32x2*)(lds + 36864);
            for (int i = tid; i < 9 * 1024; i += 512) { const int mb = i >> 10, k = i & 1023; const float c = mb == 0 ? p.in[7][k] : p.in[6][(mb - 1) * 1024 + k];
                sl[i] = c * sigmoidf_(c); }
            __syncthreads();
            for (int item = bid; item < 256; item += G) {
                const int l = item >> 7, cb = item & 127, lc = lane < 36 ? lane : 35, col0 = cb * 72 + 2 * lc;
                const float* W = p.in[8] + (size_t)l * 1024 * 9216 + col0;
                float a0[9], a1[9];
#pragma unroll
                for (int mb = 0; mb < 9; ++mb) { a0[mb] = 0.f; a1[mb] = 0.f; }
#pragma unroll 8
                for (int k = wave * 128; k < wave * 128 + 128; ++k) {
                    const f32x2 wv = *(const f32x2*)(W + (size_t)k * 9216);
#pragma unroll
                    for (int mb = 0; mb < 9; ++mb) { const float s = sl[mb * 1024 + k]; a0[mb] += s * wv.x; a1[mb] += s * wv.y; }
                }
#pragma unroll
                for (int mb = 0; mb < 9; ++mb) red[(wave * 9 + mb) * 64 + lane] = (f32x2){a0[mb], a1[mb]};
                __syncthreads();
                for (int idx = tid; idx < 9 * 64; idx += 512) {
                    const int mb = idx >> 6, ln = idx & 63; f32x2 s = (f32x2){0.f, 0.f};
#pragma unroll
                    for (int wv = 0; wv < 8; ++wv) s = s + red[(wv * 9 + mb) * 64 + ln];
                    const int col = cb * 72 + 2 * ln;
                    if (ln < 36) { const f32x2 bv = *(const f32x2*)(p.in[9] + (size_t)l * 9216 + col);
                        *(f32x2*)(MOD + (size_t)(l * 9 + mb) * 9216 + col) = s + bv; }
                }
                __syncthreads();
            }
            if (bid == G - 1) {
                const int pos = tid >> 3, i = tid & 7;
                const float inv = __builtin_amdgcn_exp2f(-(float)i * 1.6609640474436813f);
                const float ang = (float)pos * inv;
                double rr = (double)ang * 0.15915494309189535; rr -= __builtin_rint(rr);
                const float rf = (float)rr;
                ROPE[pos * 8 + i] = (f32x2){__builtin_amdgcn_cosf(rf), __builtin_amdgcn_sinf(rf)};
            }
            { const int n4 = (8 * 2 * 8 * 256 * 64) / 4;
              for (int i = bid * 512 + tid; i < 2 * n4; i += G * 512) {
                  const bool kk = i < n4; const int j = kk ? i : i - n4;
                  const f32x4 v = *((const f32x4*)(kk ? p.in[2] : p.in[3]) + j);
                  u32x2 o; o.x = cvt_pk_bf16(v[0], v[1]); o.y = cvt_pk_bf16(v[2], v[3]);
                  *((u32x2*)(kk ? CK : CV) + j) = o; } }
        }
        }
        ph = 1;
        xcd_barrier(xb, wave_s);
    }
    if (p.ph_hi < 0) grid.sync();
    int did = 0; (void)did;
    for (; ph < p.ph_hi; ++ph) {
#define PHASE_IDS() int tid = wave_s * 64 + lane_id_v(); asm volatile("" : "+v"(tid)); int bid = blockIdx.x; asm volatile("" : "+s"(bid)); \
        const int lane = tid & 63, wave = __builtin_amdgcn_readfirstlane(tid >> 6); const int gw = bid * 8 + wave, NGW = G * 8; (void)lane; (void)gw; (void)NGW;
        if (ph == 27) {
            if (G == 256) break;
            PHASE_IDS();
            const float* g = ldptr(tab, 29);
            const float* ss = SS + 6 * M;
            for (int r = gw; r < M; r += NGW) {
                f32x4* xr = (f32x4*)(X + (size_t)r * D) + lane;
                const float rstd = rsqrtf(ss[r] * (1.f / D) + EPS);
#pragma unroll
                for (int j = 0; j < 4; ++j) { const f32x4 gv = *((const f32x4*)g + lane + 64 * j); xr[64 * j] = xr[64 * j] * rstd * gv; }
            }
        } else {
            const int l = (ph - 1) / 13, k = (ph - 1) % 13;
            const float* modl = MOD + (size_t)l * 9 * 9216;
            float* SWl = SW + (size_t)l * 27 * 6656;
            if (k == 0) {
                PHASE_IDS();
                if (l == 0) {
                    const float* g = ldptr(tab, 10);
                    for (int r = gw; r < M; r += NGW) {
                        const float* src = r < MP ? ldptr(tab, 0) + (size_t)r * D : ldptr(tab, 1) + (size_t)(r - MP) * D;
                        const f32x4* xr = (const f32x4*)src + lane;
                        const float* mv = modl + (size_t)mod_index(r) * 9216 + 1024;
                        f32x4 v[4]; float s = 0.f;
#pragma unroll
                        for (int j = 0; j < 4; ++j) { v[j] = xr[64 * j]; s += (v[j].x * v[j].x + v[j].y * v[j].y) + (v[j].z * v[j].z + v[j].w * v[j].w); }
                        s = wave_sum(s, lane);
                        if (lane == 0) SS[r] = s;
                        f32x4* xo = (f32x4*)(X + (size_t)r * D) + lane;
                        u32x2* ho = (u32x2*)(H + (size_t)r * D) + lane;
#pragma unroll
                        for (int j = 0; j < 4; ++j) {
                            xo[64 * j] = v[j];
                            const f32x4 gv = *((const f32x4*)g + lane + 64 * j), sc = *((const f32x4*)mv + lane + 64 * j);
                            const f32x4 h = v[j] * gv * (sc + 1.f);
                            u32x2 o; o.x = cvt_pk_bf16(h[0], h[1]); o.y = cvt_pk_bf16(h[2], h[3]); ho[64 * j] = o;
                        }
                    }
                }
                if (l == 0) CONVERT_RANGE(0, gw, CV_NIT)
            } else if (k == 1) {
            } else if (k == 2 || k == 11) {
                PHASE_IDS();
                pg8::Gemm g{H, WB + (k == 2 ? WO_GU1 : WO_GU2), D, D, D};
                pg8::StaticOrder S; S.init(M, 5632, G, bid);
                EpiSwiglu E{ACT, SS + (size_t)(3 * l + (k == 2 ? 0 : 2)) * M, SWl + (size_t)(k == 2 ? 0 : 2) * 9 * 6656};
                pg8::gemm_phase<EpiSwiglu>(lds, tid, g, S, E);
            } else if (k == 3 || k == 12 || k == 10) {
                PHASE_IDS();
                pg8::Gemm g;
                if (k == 10) g = pg8::Gemm{U + UC_Z, WB + WO_O, UN, D, D};
                else g = pg8::Gemm{ACT, WB + (k == 3 ? WO_D1 : WO_D2), FF, FF, FF};
                pg8::StaticOrder S; S.init(M, D, G, bid);
                const int w = k == 3 ? 1 : (k == 10 ? 2 : 3);
                const int ln = w == 3 ? l + 1 : l, wn = w == 3 ? 0 : w;
                const bool hasn = ln < NL;
                if (!hasn && G == 256) {
                    EpiResidT<true> E{X, ws, 0.5f, l * 9 * 9216 + 8 * 1024, 3 * l + w, -2, 0};
                    pg8::gemm_phase<EpiResidT<true>>(lds, tid, g, S, E);
                } else {
                    EpiResidT<false> E{X, ws, k == 10 ? 1.0f : 0.5f, l * 9 * 9216 + (k == 3 ? 2 : (k == 10 ? 5 : 8)) * 1024, 3 * l + w,
                               hasn ? (ln * 3 + wn) * D : -1, (hasn ? ln : 0) * 9 * 9216 + (3 * wn + 1) * 1024};
                    pg8::gemm_phase<EpiResidT<false>>(lds, tid, g, S, E);
                    if (k == 12 && l + 1 < NL) {
                        int tid_c = wave_s * 64 + lane_id_v(); asm volatile("" : "+v"(tid_c));
                        const int lane = tid_c & 63, wave = __builtin_amdgcn_readfirstlane(tid_c >> 6); const int gw = (int)blockIdx.x * 8 + wave, NGW = G * 8;
                        CONVERT_RANGE(l + 1, gw, CV_NIT - CV_IF)
                    }
                }
            } else if (k == 4) {
                PHASE_IDS();
                pg8::Gemm g{H, WB + WO_IN, D, D, D};
                pg8::StaticOrder S; S.init(M, UN, G, bid);
                EpiIn E{U, p.out, l, SS + (size_t)(3 * l + 1) * M, SWl + (size_t)1 * 9 * 6656};
                pg8::gemm_phase<EpiIn>(lds, tid, g, S, E);
            } else if (k == 5) {
                PHASE_IDS();
                const float* cw = ldptr(tab, 18) + (size_t)l * 3 * 512; const float* cbias = ldptr(tab, 19) + (size_t)l * 512;
                const float* qn = ldptr(tab, 21) + (size_t)l * 256; const float* kvn = ldptr(tab, 23) + (size_t)l * 128;
#define PREP_LOAD(R_, X) \
                    const int r##X = (R_); const bf16_t* ur##X = U + (size_t)r##X * UN; \
                    const bool smp##X = r##X >= MP; const int s##X = smp##X ? ((r##X - MP) & 1023) : (r##X & 255); \
                    const bool hasp##X = s##X != 0, hasn##X = smp##X ? (s##X != 1023) : (s##X != 255); \
                    const int c##X = 8 * lane; \
                    const u32x4 bg##X = *(const u32x4*)(ur##X + UC_BG + c##X), cg0##X = *(const u32x4*)(ur##X + UC_CG + c##X), xc0##X = *(const u32x4*)(ur##X + UC_XC + c##X); \
                    u32x4 cgp##X = (u32x4){0u, 0u, 0u, 0u}, xcp##X = cgp##X, cgn##X = cgp##X, xcn##X = cgp##X; \
                    if (hasp##X) { cgp##X = *(const u32x4*)(ur##X - UN + UC_CG + c##X); xcp##X = *(const u32x4*)(ur##X - UN + UC_XC + c##X); } \
                    if (hasn##X) { cgn##X = *(const u32x4*)(ur##X + UN + UC_CG + c##X); xcn##X = *(const u32x4*)(ur##X + UN + UC_XC + c##X); } \
                    const u32x2 vq##X = *(const u32x2*)(ur##X + UC_CQ + 4 * lane); \
                    const unsigned vk##X = *(const unsigned*)(ur##X + UC_CKV + 2 * lane); \
                    const bf16_t vr##X = ur##X[UC_KR + (lane & 31)];
#define PREP_DONE(X) { \
                    u32x4 ycw; \
                    {   float o[8]; \
                        _Pragma("unroll") for (int q = 0; q < 4; ++q) { \
                            _Pragma("unroll") for (int hh = 0; hh < 2; ++hh) { \
                                const int ch = c##X + 2 * q + hh; \
                                const float pb = hh ? bf_hi(bg##X[q]) : bf_lo(bg##X[q]); \
                                const float pc = (hh ? bf_hi(cg0##X[q]) : bf_lo(cg0##X[q])) * (hh ? bf_hi(xc0##X[q]) : bf_lo(xc0##X[q])); \
                                const float pp = (hh ? bf_hi(cgp##X[q]) : bf_lo(cgp##X[q])) * (hh ? bf_hi(xcp##X[q]) : bf_lo(xcp##X[q])); \
                                const float pn = (hh ? bf_hi(cgn##X[q]) : bf_lo(cgn##X[q])) * (hh ? bf_hi(xcn##X[q]) : bf_lo(xcn##X[q])); \
                                o[2 * q + hh] = pb * (cbias[ch] + cw[ch] * pp + cw[512 + ch] * pc + cw[1024 + ch] * pn); \
                            } \
                        } \
                        ycw.x = cvt_pk_bf16(o[0], o[1]); ycw.y = cvt_pk_bf16(o[2], o[3]); ycw.z = cvt_pk_bf16(o[4], o[5]); ycw.w = cvt_pk_bf16(o[6], o[7]); \
                    } \
                    {   const float a0 = bf_lo(vq##X.x), a1 = bf_hi(vq##X.x), a2 = bf_lo(vq##X.y), a3 = bf_hi(vq##X.y); \
                        const float rstd = 1.f / sqrtf(wave_sum(a0 * a0 + a1 * a1 + a2 * a2 + a3 * a3, lane) * (1.f / 256.f) + EPS); \
                        const f32x4 gq = *(const f32x4*)(qn + 4 * lane); \
                        u32x2 o; o.x = cvt_pk_bf16(a0 * rstd * gq[0], a1 * rstd * gq[1]); o.y = cvt_pk_bf16(a2 * rstd * gq[2], a3 * rstd * gq[3]); \
                        *(u32x2*)(CQN + (size_t)r##X * 256 + 4 * lane) = o; \
                    } \
                    {   const float a0 = bf_lo(vk##X), a1 = bf_hi(vk##X); \
                        const float rstd = 1.f / sqrtf(wave_sum(a0 * a0 + a1 * a1, lane) * (1.f / 128.f) + EPS); \
                        const f32x2 gk = *(const f32x2*)(kvn + 2 * lane); \
                        const float o0 = a0 * rstd * gk.x, o1 = a1 * rstd * gk.y; \
                        *(unsigned*)(CKVN + (size_t)r##X * 128 + 2 * lane) = cvt_pk_bf16(o0, o1); \
                        if (!smp##X) *(f32x2*)(p.out + OUT_CKV + ((size_t)((r##X >> 8) * 2 + l) * 256 + (r##X & 255)) * 128 + 2 * lane) = (f32x2){o0, o1}; \
                    } \
                    {   const int e = lane & 31; \
                        float v = bf1(vr##X); \
                        const float pr = shfl_x(v, 8, lane); \
                        if (smp##X) { \
                            const int pos = (e >= 16) ? (s##X & 63) : (s##X >> 6); \
                            const f32x2 cs = ROPE[pos * 8 + (e & 7)]; \
                            v = (e & 8) ? (pr * cs.y + v * cs.x) : (v * cs.x - pr * cs.y); \
                        } \
                        if (lane < 32) KR[(size_t)r##X * 32 + e] = f2bf(v); \
                    } \
                    *(u32x4*)((bf16_t*)ur##X + UC_YC + 8 * lane) = ycw;     \
                }
                for (int r = gw; r < M; r += 2 * NGW) {
                    const int r2 = r + NGW; const bool two = r2 < M;
                    PREP_LOAD(r, A)
                    PREP_LOAD(two ? r2 : r, B)
                    PREP_DONE(A)
                    if (two) PREP_DONE(B)
                }
#undef PREP_LOAD
#undef PREP_DONE
                if (l > 0) CONVERT_RANGE(l, CV_NIT - CV_IF + gw, CV_NIT)
                for (int r = M + gw; r < M + 2048; r += NGW) {
                    const int idx = r - M, b = idx >> 8, pp = idx & 255;
                    const f32x2 v = *(const f32x2*)(ldptr(tab, 4) + ((size_t)(b * 2 + l) * 256 + pp) * 128 + 2 * lane);
                    *(unsigned*)(CKVN + (size_t)r * 128 + 2 * lane) = cvt_pk_bf16(v.x, v.y);
                    if (lane < 32) KR[(size_t)r * 32 + lane] = f2bf(ldptr(tab, 5)[((size_t)(b * 2 + l) * 256 + pp) * 32 + lane]);
                }
            } else if (k == 6) {
                PHASE_IDS();
                int kq = 256; asm volatile("" : "+s"(kq));
                pg8::Gemm g{CQN, WB + WO_UQ, kq, kq, kq};
                pg8::StaticOrder S; S.init(M, 768, G, bid);
                EpiQ E{U, ROPE};
                pg8::gemm_phase<EpiQ>(lds, tid, g, S, E);
            } else if (k == 7) {
                PHASE_IDS();
                int kk_ = 128; asm volatile("" : "+s"(kk_));
                pg8::Gemm g{CKVN, WB + WO_UKV, kk_, kk_, kk_};
                pg8::StaticOrder S; S.init(M + 2048, 1024, G, (bid + 192) % G);
                EpiPlain E{KVX, 1024};
                pg8::gemm_phase<EpiPlain>(lds, tid, g, S, E);
            } else if (k == 8) {
                PHASE_IDS();
                const float sc_na = 0.125f * LOG2E, sc_mla = 0.10206207261596575f * LOG2E;
                const int ona_col = UC_ONA;
                for (int u = bid; u < 1024; u += G) {
                    const int type = u >> 8, v = u & 255;
                    if (type == 0) {
                        const int bh = (v & 7) + 8 * (v >> 5), b = bh >> 3, h = bh & 7, qb = (v >> 3) & 3;
                        const size_t r0 = MP + (size_t)b * 1024, rq = r0 + qb * 256, rc = M + (size_t)b * 256;
                        AttnSeg s0{(unsigned)(WS_KVX + (rc * 1024 + h * 128) * 2), (unsigned)(WS_H + HO_KR + rc * 32 * 2), (unsigned)(WS_KVX + (rc * 1024 + h * 128 + 64) * 2), 1024, 32, 1024, 256};
                        AttnSeg s1{(unsigned)(WS_KVX + (r0 * 1024 + h * 128) * 2), (unsigned)(WS_H + HO_KR + r0 * 32 * 2), (unsigned)(WS_KVX + (r0 * 1024 + h * 128 + 64) * 2), 1024, 32, 1024, 1024};
                        attn_unit<96, false>(lds, tid, ws, U + rq * UN + UC_QM + h * 96, UN, U + rq * UN + UC_OM + h * 64, UN, s0, s1, sc_mla, 0, 0, nullptr);
                    } else if (type == 1) {
                        const int bh = (v & 7) + 8 * (v >> 5), b = bh >> 3, h = bh & 7, qb = (v >> 3) & 3;
                        const size_t r0 = MP + (size_t)b * 1024, rq = r0 + qb * 256;
                        const int qrow0 = 4 * qb, rb0 = min(max(qrow0 - 4, 0), 8), rb1 = min(max(qrow0 + 3 - 4, 0), 8) + 8;
                        const size_t co = ((size_t)((b * 2 + l) * 8 + h) * 256) * 64;
                        AttnSeg s0{(unsigned)(WS_CK + co * 2), (unsigned)(WS_CK + co * 2), (unsigned)(WS_CV + co * 2), 64, 64, 64, 256};
                        const size_t rl = r0 + (size_t)rb0 * 64;
                        AttnSeg s1{(unsigned)(WS_U + (rl * UN + UC_KNA + h * 64) * 2), (unsigned)(WS_U + (rl * UN + UC_KNA + h * 64) * 2), (unsigned)(WS_U + (rl * UN + UC_VNA + h * 64) * 2), UN, UN, UN, (rb1 - rb0) * 64};
                        attn_unit<64, true>(lds, tid, ws, U + rq * UN + UC_QNA + h * 64, UN, U + rq * UN + ona_col + h * 64, UN, s0, s1, sc_na, qrow0, rb0,
                                            ldptr(tab, 20) + (size_t)(l * 8 + h) * 465);
                    } else if (type == 2) {
                        const int b = v >> 3, h = v & 7;
                        const size_t r0 = (size_t)b * 256;
                        AttnSeg s0{(unsigned)(WS_U + (r0 * UN + UC_KNA + h * 64) * 2), (unsigned)(WS_U + (r0 * UN + UC_KNA + h * 64) * 2), (unsigned)(WS_U + (r0 * UN + UC_VNA + h * 64) * 2), UN, UN, UN, 256};
                        AttnSeg s1 = s0; s1.nkeys = 0;
                        attn_unit<64, false>(lds, tid, ws, U + r0 * UN + UC_QNA + h * 64, UN, U + r0 * UN + ona_col + h * 64, UN, s0, s1, sc_na, 0, 0, nullptr);
                    } else {
                        const int b = v >> 3, h = v & 7;
                        const size_t r0 = (size_t)b * 256;
                        AttnSeg s0{(unsigned)(WS_KVX + (r0 * 1024 + h * 128) * 2), (unsigned)(WS_H + HO_KR + r0 * 32 * 2), (unsigned)(WS_KVX + (r0 * 1024 + h * 128 + 64) * 2), 1024, 32, 1024, 256};
                        AttnSeg s1 = s0; s1.nkeys = 0;
                        attn_unit<96, false>(lds, tid, ws, U + r0 * UN + UC_QM + h * 96, UN, U + r0 * UN + UC_OM + h * 64, UN, s0, s1, sc_mla, 0, 0, nullptr);
                    }
                }
            } else if (k == 9) {
                PHASE_IDS();
                pg8::Gemm g{U, WB + WO_C, UN, 512, 512};
                pg8::StaticOrder S; S.init(M, D, G, bid, 3);
                EpiZ3 E{U};
                pg8::gemm_phase<EpiZ3, true>(lds, tid, g, S, E);
            }
        }
        if (ph + 1 < p.ph_hi && !(ph != 27 && ((ph - 1) % 13) == 6) && !(ph != 27 && ((ph - 1) % 13) == 1) && !(ph == 14) && !(ph == 26 && G == 256)) xcd_barrier(xb, wave_s);
        if (PROBE_MASK != 0) { if (ph != 27 && ((PROBE_MASK >> ((ph - 1) % 13)) & 1) && !did) { did = 1; if (((ph - 1) % 13) == 6) xcd_barrier(xb, wave_s); --ph; } else did = 0; }
        for (int sr = 0; sr < PROBE_SYNC; ++sr) xcd_barrier(xb, wave_s);
    }
}

extern "C" void kernel_launch(void* const* d_in, const int* in_sizes, int n_in, void* d_out, int out_size, void* d_ws, size_t ws_size, hipStream_t stream) {
    static int grid = 0;
    if (grid == 0) {
        if (n_in != 30 || ws_size < WS_END) { fprintf(stderr, "kernel_launch: unexpected n_in %d / ws_size %zu\n", n_in, ws_size); grid = -1; return; }
        int dev = 0, cus = 0, per_cu = 0;
        hipGetDevice(&dev);
        hipDeviceGetAttribute(&cus, hipDeviceAttributeMultiprocessorCount, dev);
        hipFuncSetAttribute((const void*)fwd_kernel, hipFuncAttributeMaxDynamicSharedMemorySize, LDS_BYTES);
        hipOccupancyMaxActiveBlocksPerMultiprocessor(&per_cu, (const void*)fwd_kernel, 512, LDS_BYTES);
        if (per_cu < 1) { fprintf(stderr, "kernel_launch: occupancy query says %d blocks/CU\n", per_cu); per_cu = 1; }
        if (per_cu > 1) per_cu = 1;
        grid = cus * per_cu;
        (void)hipGetLastError();
    }
    if (grid < 0) return;
    if (hipMemsetAsync((char*)d_ws + WS_BAR, 0, XCD_BAR_WORDS * 4, stream) != hipSuccess) { fprintf(stderr, "memset(bar) failed\n"); return; }
    Params p{};
    for (int i = 0; i < 30; ++i) p.in[i] = (const float*)d_in[i];
    p.out = (float*)d_out; p.ws = (unsigned char*)d_ws; p.ph_lo = 0; p.ph_hi = 28;
    void* args[] = {&p};
    hipError_t e = hipLaunchCooperativeKernel((const void*)fwd_kernel, dim3(grid), dim3(512), args, LDS_BYTES, stream);
    if (e != hipSuccess) fprintf(stderr, "cooperative launch failed: %s (grid %d)\n", hipGetErrorString(e), grid);
}
```
